# Optimizing an MI355X kernel written in HIP

```python
import math
import jax, jax.numpy as jnp
from jax import lax
import numpy as np

D_MODEL = 1024
BATCH = 2
SEQ = 8192
DEPTH = 2

N_BRANCHES = 4
HEAD_DIM = 64
N_HEADS = D_MODEL // (N_BRANCHES * HEAD_DIM)
W_MIX = N_HEADS * HEAD_DIM
DIFF_QK_DIM = HEAD_DIM // 2
FOX_FORGET_BIAS = 3.0
NSA_CMP_BLOCK = 32
NSA_CMP_STRIDE = 16
NSA_SLC_BLOCK = 64
NSA_TOPK = 16
NSA_WINDOW = 512
NSA_PHI_HIDDEN = 256
NSA_FORCE_SCORE = 1.0e4
GMLP_CHUNK = 128
Q_BLOCK = 128
D_FF = 2816
RMS_EPS = 1e-6
IN_SPLIT_SIZES = (W_MIX, W_MIX, W_MIX,
                  W_MIX, W_MIX, W_MIX, N_HEADS,
                  W_MIX, 6 * HEAD_DIM, 3 * N_HEADS,
                  2 * W_MIX,
                  N_BRANCHES * D_MODEL)
D_IN = sum(IN_SPLIT_SIZES)

kernel_name = "hybrid_diff_fox_nsa_gmlp_macaron"


def rms_norm(x, g=None):
    xf = x.astype(jnp.float32)
    y = xf * lax.rsqrt(jnp.mean(xf * xf, axis=-1, keepdims=True) + RMS_EPS)
    if g is not None:
        y = y * g.astype(jnp.float32)
    return y.astype(x.dtype)


def masked_softmax(s, mask):
    s = jnp.where(mask, s.astype(jnp.float32), -jnp.inf)
    m = jnp.max(s, axis=-1, keepdims=True)
    m = jnp.where(jnp.isfinite(m), m, 0.0)
    p = jnp.exp(s - m)
    return p / jnp.maximum(jnp.sum(p, axis=-1, keepdims=True), 1e-30)


def split_cols(z, sizes):
    idx = np.cumsum(np.array(sizes))[:-1].tolist()
    return jnp.split(z, idx, axis=-1)


def blocks_to_seq(o):
    nq, b, qb, h, d = o.shape
    return o.transpose(1, 0, 2, 3, 4).reshape(b, nq * qb, h, d)


def swiglu(h, w_in, w_out):
    a, b = jnp.split(h @ w_in, 2, axis=-1)
    return (jax.nn.silu(a) * b) @ w_out


def diff_attention(q, k, v, lam):
    T = q.shape[1]
    scale = q.shape[-1] ** -0.5
    kpos = jnp.arange(T)

    def block(i):
        q0 = i * Q_BLOCK
        qb = lax.dynamic_slice_in_dim(q, q0, Q_BLOCK, axis=1)
        s = jnp.einsum('bqhcd,bkhcd->bchqk', qb, k) * scale
        qpos = q0 + jnp.arange(Q_BLOCK)
        p = masked_softmax(s, kpos[None, :] <= qpos[:, None])
        w = p[:, 0] - lam * p[:, 1]
        return jnp.einsum('bhqk,bkhd->bqhd', w.astype(v.dtype), v)

    return blocks_to_seq(lax.map(block, jnp.arange(T // Q_BLOCK)))


def forgetting_attention(q, k, v, log_f):
    T = q.shape[1]
    scale = q.shape[-1] ** -0.5
    c = jnp.cumsum(log_f, axis=1).transpose(0, 2, 1)
    kpos = jnp.arange(T)

    def block(i):
        q0 = i * Q_BLOCK
        qb = lax.dynamic_slice_in_dim(q, q0, Q_BLOCK, axis=1)
        cq = lax.dynamic_slice_in_dim(c, q0, Q_BLOCK, axis=2)
        s = jnp.einsum('bqhd,bkhd->bhqk', qb, k).astype(jnp.float32) * scale
        s = s + cq[..., :, None] - c[..., None, :]
        qpos = q0 + jnp.arange(Q_BLOCK)
        p = masked_softmax(s, kpos[None, :] <= qpos[:, None])
        return jnp.einsum('bhqk,bkhd->bqhd', p.astype(v.dtype), v)

    return blocks_to_seq(lax.map(block, jnp.arange(T // Q_BLOCK)))


def nsa_compress(x, pe, w1, b1, w2, b2):
    B, T, D = x.shape
    xb = x.reshape(B, T // NSA_CMP_STRIDE, NSA_CMP_STRIDE, D)
    blocks = jnp.concatenate([xb[:, :-1], xb[:, 1:]], axis=2)
    zf = (blocks + pe).reshape(B, blocks.shape[1], NSA_CMP_BLOCK * D)
    return jax.nn.gelu(zf @ w1 + b1) @ w2 + b2


def nsa_attention(q, kc, vc, ks, vs, kw, vw, gates):
    B, T, H, D = q.shape
    nc = kc.shape[1]
    ns = T // NSA_SLC_BLOCK
    n_top = min(NSA_TOPK, ns)
    scale = D ** -0.5
    cidx = jnp.arange(nc)
    sidx = jnp.arange(ns)
    cmp_end = cidx * NSA_CMP_STRIDE + NSA_CMP_BLOCK - 1
    overlap = ((cidx[:, None] * NSA_CMP_STRIDE < (sidx[None, :] + 1) * NSA_SLC_BLOCK)
               & (cidx[:, None] * NSA_CMP_STRIDE + NSA_CMP_BLOCK > sidx[None, :] * NSA_SLC_BLOCK)
               ).astype(jnp.float32)
    ks_blocks = ks.reshape(B, ns, NSA_SLC_BLOCK, D)
    vs_blocks = vs.reshape(B, ns, NSA_SLC_BLOCK, D)
    kw_pad = jnp.pad(kw, ((0, 0), (NSA_WINDOW, 0), (0, 0)))
    vw_pad = jnp.pad(vw, ((0, 0), (NSA_WINDOW, 0), (0, 0)))
    tok_off = jnp.arange(NSA_SLC_BLOCK)
    win_off = jnp.arange(NSA_WINDOW + Q_BLOCK) - NSA_WINDOW
    gather = jax.vmap(lambda blocks, idx: blocks[idx])
    n_sel = n_top * NSA_SLC_BLOCK

    def block(i):
        q0 = i * Q_BLOCK
        qpos = q0 + jnp.arange(Q_BLOCK)
        qb = lax.dynamic_slice_in_dim(q, q0, Q_BLOCK, axis=1)
        gb = jax.nn.sigmoid(lax.dynamic_slice_in_dim(gates, q0, Q_BLOCK, axis=1).astype(jnp.float32))
        s_c = jnp.einsum('bqhd,bnd->bhqn', qb, kc) * scale
        p_c = masked_softmax(s_c, cmp_end[None, :] <= qpos[:, None])
        o_c = jnp.einsum('bhqn,bnd->bqhd', p_c.astype(vc.dtype), vc)
        imp = jnp.einsum('bhqn,nj->bqj', p_c, overlap)
        cur = qpos // NSA_SLC_BLOCK
        forced = ((sidx[None, :] == 0) | (sidx[None, :] == cur[:, None])
                  | (sidx[None, :] == cur[:, None] - 1))
        valid = sidx[None, :] * NSA_SLC_BLOCK <= qpos[:, None]
        imp = jnp.where(forced, NSA_FORCE_SCORE, jnp.where(valid, imp, -1.0))
        _, sel = lax.top_k(imp, n_top)
        kg = gather(ks_blocks, sel).reshape(B, Q_BLOCK, n_sel, D)
        vg = gather(vs_blocks, sel).reshape(B, Q_BLOCK, n_sel, D)
        tok = (sel[..., None] * NSA_SLC_BLOCK + tok_off).reshape(B, Q_BLOCK, n_sel)
        s_s = jnp.einsum('bqhd,bqmd->bhqm', qb, kg) * scale
        p_s = masked_softmax(s_s, (tok <= qpos[None, :, None])[:, None])
        o_s = jnp.einsum('bhqm,bqmd->bqhd', p_s.astype(vg.dtype), vg)
        kwb = lax.dynamic_slice_in_dim(kw_pad, q0, NSA_WINDOW + Q_BLOCK, axis=1)
        vwb = lax.dynamic_slice_in_dim(vw_pad, q0, NSA_WINDOW + Q_BLOCK, axis=1)
        kpos = q0 + win_off
        dist = qpos[:, None] - kpos[None, :]
        mask_w = (kpos[None, :] >= 0) & (dist >= 0) & (dist < NSA_WINDOW)
        s_w = jnp.einsum('bqhd,bkd->bhqk', qb, kwb) * scale
        p_w = masked_softmax(s_w, mask_w)
        o_w = jnp.einsum('bhqk,bkd->bqhd', p_w.astype(vwb.dtype), vwb)
        g = gb.astype(q.dtype)
        return g[..., 0:1] * o_c + g[..., 1:2] * o_s + g[..., 2:3] * o_w

    return blocks_to_seq(lax.map(block, jnp.arange(T // Q_BLOCK)))


def chunked_spatial_gating(uv, v_gain, w_s, b_s):
    B, T, _ = uv.shape
    u, v = jnp.split(jax.nn.gelu(uv), 2, axis=-1)
    v = rms_norm(v.reshape(B, T, N_HEADS, HEAD_DIM), v_gain.reshape(N_HEADS, HEAD_DIM))
    v = v.reshape(B, T // GMLP_CHUNK, GMLP_CHUNK, N_HEADS, HEAD_DIM)
    w = w_s * jnp.tril(jnp.ones((GMLP_CHUNK, GMLP_CHUNK), w_s.dtype))
    sv = jnp.einsum('gts,bcsgd->bctgd', w, v) + b_s.T[:, :, None]
    return u * sv.reshape(B, T, W_MIX)


def setup_inputs(seed: int = 0) -> dict:
    key = jax.random.key(seed)
    keys = list(jax.random.split(key, 32))

    def nrm(shape, scale):
        return jax.random.normal(keys.pop(), shape, jnp.float32) * scale

    L, D = DEPTH, D_MODEL
    return {
        "x": nrm((BATCH, SEQ, D), 1.0),
        "ffn1_norm": 1.0 + nrm((L, D), 0.02),
        "ffn1_w_in": nrm((L, D, 2 * D_FF), D ** -0.5),
        "ffn1_w_out": nrm((L, D_FF, D), D_FF ** -0.5),
        "mix_norm": 1.0 + nrm((L, D), 0.02),
        "w_in": nrm((L, D, D_IN), D ** -0.5),
        "diff_q_gain": 1.0 + nrm((L, DIFF_QK_DIM), 0.02),
        "diff_k_gain": 1.0 + nrm((L, DIFF_QK_DIM), 0.02),
        "diff_lambda": nrm((L, 4, DIFF_QK_DIM), 0.1),
        "fox_q_gain": 1.0 + nrm((L, HEAD_DIM), 0.02),
        "fox_k_gain": 1.0 + nrm((L, HEAD_DIM), 0.02),
        "fox_f_bias": FOX_FORGET_BIAS + nrm((L, N_HEADS), 0.1),
        "nsa_q_gain": 1.0 + nrm((L, HEAD_DIM), 0.02),
        "nsa_k_gain": 1.0 + nrm((L, HEAD_DIM), 0.02),
        "nsa_cmp_pe": nrm((L, 2, NSA_CMP_BLOCK, HEAD_DIM), 0.1),
        "nsa_phi_w1": nrm((L, 2, NSA_CMP_BLOCK * HEAD_DIM, NSA_PHI_HIDDEN), (NSA_CMP_BLOCK * HEAD_DIM) ** -0.5),
        "nsa_phi_b1": nrm((L, 2, NSA_PHI_HIDDEN), 0.02),
        "nsa_phi_w2": nrm((L, 2, NSA_PHI_HIDDEN, HEAD_DIM), NSA_PHI_HIDDEN ** -0.5),
        "nsa_phi_b2": nrm((L, 2, HEAD_DIM), 0.02),
        "gmlp_v_gain": 1.0 + nrm((L, W_MIX), 0.02),
        "gmlp_w_s": nrm((L, N_HEADS, GMLP_CHUNK, GMLP_CHUNK), GMLP_CHUNK ** -0.5),
        "gmlp_b_s": 1.0 + nrm((L, N_HEADS, GMLP_CHUNK), 0.02),
        "w_branch": nrm((L, N_BRANCHES, W_MIX, D), W_MIX ** -0.5),
        "w_out": nrm((L, D, D), D ** -0.5),
        "ffn2_norm": 1.0 + nrm((L, D), 0.02),
        "ffn2_w_in": nrm((L, D, 2 * D_FF), D ** -0.5),
        "ffn2_w_out": nrm((L, D_FF, D), D_FF ** -0.5),
    }


def reference(x, ffn1_norm, ffn1_w_in, ffn1_w_out, mix_norm, w_in, diff_q_gain, diff_k_gain,
              diff_lambda, fox_q_gain, fox_k_gain, fox_f_bias, nsa_q_gain, nsa_k_gain, nsa_cmp_pe,
              nsa_phi_w1, nsa_phi_b1, nsa_phi_w2, nsa_phi_b2, gmlp_v_gain, gmlp_w_s, gmlp_b_s,
              w_branch, w_out, ffn2_norm, ffn2_w_in, ffn2_w_out):
    B, T, _ = x.shape
    for l in range(DEPTH):
        x = x + 0.5 * swiglu(rms_norm(x, ffn1_norm[l]), ffn1_w_in[l], ffn1_w_out[l])

        h = rms_norm(x, mix_norm[l])
        z = h @ w_in[l]
        (a_q, a_k, a_v, f_q, f_k, f_v, f_logit, n_q, n_kv, n_g, g_uv, m_g) = split_cols(z, IN_SPLIT_SIZES)

        a_q = rms_norm(a_q.reshape(B, T, N_HEADS, 2, DIFF_QK_DIM), diff_q_gain[l])
        a_k = rms_norm(a_k.reshape(B, T, N_HEADS, 2, DIFF_QK_DIM), diff_k_gain[l])
        a_v = a_v.reshape(B, T, N_HEADS, HEAD_DIM)
        lam_init = 0.8 - 0.6 * math.exp(-0.3 * l)
        lam_p = diff_lambda[l].astype(jnp.float32)
        lam = (jnp.exp(jnp.sum(lam_p[0] * lam_p[1])) - jnp.exp(jnp.sum(lam_p[2] * lam_p[3])) + lam_init)
        o_a = rms_norm(diff_attention(a_q, a_k, a_v, lam)) * (1.0 - lam_init)

        f_q = rms_norm(f_q.reshape(B, T, N_HEADS, HEAD_DIM), fox_q_gain[l])
        f_k = rms_norm(f_k.reshape(B, T, N_HEADS, HEAD_DIM), fox_k_gain[l])
        f_v = f_v.reshape(B, T, N_HEADS, HEAD_DIM)
        log_f = jax.nn.log_sigmoid(f_logit.astype(jnp.float32) + fox_f_bias[l].astype(jnp.float32))
        o_b = forgetting_attention(f_q, f_k, f_v, log_f)

        n_q = rms_norm(n_q.reshape(B, T, N_HEADS, HEAD_DIM), nsa_q_gain[l])
        kc_in, vc_in, k_s, v_s, k_w, v_w = jnp.split(n_kv, 6, axis=-1)
        k_c = rms_norm(nsa_compress(kc_in, nsa_cmp_pe[l, 0], nsa_phi_w1[l, 0], nsa_phi_b1[l, 0],
                                    nsa_phi_w2[l, 0], nsa_phi_b2[l, 0]), nsa_k_gain[l])
        v_c = nsa_compress(vc_in, nsa_cmp_pe[l, 1], nsa_phi_w1[l, 1], nsa_phi_b1[l, 1],
                           nsa_phi_w2[l, 1], nsa_phi_b2[l, 1])
        o_c = nsa_attention(n_q, k_c, v_c, rms_norm(k_s, nsa_k_gain[l]), v_s,
                            rms_norm(k_w, nsa_k_gain[l]), v_w, n_g.reshape(B, T, N_HEADS, 3))

        o_d = chunked_spatial_gating(g_uv, gmlp_v_gain[l], gmlp_w_s[l], gmlp_b_s[l])

        branches = jnp.stack([o_a.reshape(B, T, W_MIX), o_b.reshape(B, T, W_MIX),
                              o_c.reshape(B, T, W_MIX), o_d], axis=2)
        proj = jnp.einsum('btni,nid->btnd', branches, w_branch[l])
        gates = jax.nn.sigmoid(m_g.reshape(B, T, N_BRANCHES, D_MODEL))
        x = x + jnp.sum(gates * proj, axis=2) @ w_out[l]

        x = x + 0.5 * swiglu(rms_norm(x, ffn2_norm[l]), ffn2_w_in[l], ffn2_w_out[l])
    return x
```

```cpp
#include <hip/hip_runtime.h>
#include <hip/hip_cooperative_groups.h>
#include <cstdio>
#include <cstdint>
namespace cg = cooperative_groups;
constexpr int WIDTAB_OFF = 147456 + 2048;
__device__ __forceinline__ int otid() {
    unsigned z = 0u; asm volatile("" : "+v"(z));
    const unsigned hw = (unsigned)__builtin_amdgcn_s_getreg((5 << 11) | 4) & 63u;
    const unsigned w = *(const __attribute__((address_space(3))) unsigned*)(uintptr_t)(WIDTAB_OFF + 4u * hw + z);
    return (int)(__builtin_amdgcn_readfirstlane(w) * 64u + __builtin_amdgcn_mbcnt_hi(~0u, __builtin_amdgcn_mbcnt_lo(~0u, z)));
}
namespace pg8 {
#define PG8_LAS __attribute__((address_space(3)))
typedef unsigned short bf16_t;
typedef short bf16x8 __attribute__((ext_vector_type(8)));
typedef float f32x4 __attribute__((ext_vector_type(4)));
typedef unsigned u32x4 __attribute__((ext_vector_type(4)));
constexpr int BM = 256, BK = 64, HALF = 128, HTB = HALF * BK * 2  , STAGE_BYTES = 8 * HTB, NXCD = 8, WGM = 8;

__host__ __device__ __forceinline__ int lds_byte(int r, int c) { const int st = (r >> 4) * 2 + (c >> 5), rr = r & 15, cc = c & 31, ob = rr * 64 + cc * 2; return st * 1024 + (ob ^ (((ob >> 9) & 1) << 5)); }
__host__ __device__ __forceinline__ void stage_rc(int b, int& R, int& C) { const int st = b / 1024, sb = b % 1024, swz = sb ^ (((sb >> 9) & 1) << 5); R = (st >> 1) * 16 + swz / 64; C = (st & 1) * 32 + (swz % 64) / 2; }
__host__ __device__ __forceinline__ int perm32(int rho) { const int n = rho >> 4, i = rho & 15; return 8 * (i >> 2) + 4 * n + (i & 3); }

struct Unit { int pm, pn; };
struct Gemm { const bf16_t* A; const bf16_t* Bt; int M, N, K; };

struct StaticOrder {
    int nM, nN, nwg, G, c;
    __host__ __device__ void init(int M, int N, int G_, int c_) { nM = M / BM; nN = N / BM; nwg = nM * nN; G = G_; c = c_; }
    __host__ __device__ bool next(int i, Unit& u) const {
        const long L = (long)i * G + c; if (L >= nwg) return false;
        int wgid = (int)L; { const int q = nwg / NXCD, r = nwg % NXCD, xcd = wgid % NXCD, off = wgid / NXCD; wgid = (xcd < r ? xcd * (q + 1) : r * (q + 1) + (xcd - r) * q) + off; }
        const int nig = WGM * nN, gid = wgid / nig, fm = gid * WGM, gsz = (nM - fm) < WGM ? (nM - fm) : WGM;
        u.pm = fm + ((wgid % nig) % gsz); u.pn = (wgid % nig) / gsz; return true;
    }
    __device__ __forceinline__ void a_ready(const Unit&) const {}
    __device__ __forceinline__ void done(const Unit&) const {}
};

__device__ __forceinline__ unsigned cvt_pk_bf16(float lo, float hi) { unsigned r; asm volatile("v_cvt_pk_bf16_f32 %0, %1, %2" : "=v"(r) : "v"(lo), "v"(hi)); return r; }
typedef _Float16 f16x8 __attribute__((ext_vector_type(8)));
template <bool F16> __device__ __forceinline__ f32x4 mma16(bf16x8 b, bf16x8 a, f32x4 c) {
    if constexpr (F16) return __builtin_amdgcn_mfma_f32_16x16x32_f16(__builtin_bit_cast(f16x8, b), __builtin_bit_cast(f16x8, a), c, 0, 0, 0);
    else return __builtin_amdgcn_mfma_f32_16x16x32_bf16(b, a, c, 0, 0, 0);
}
template <class Epi, class Sched, bool ALIGN_EPI = false, bool SP2 = false, bool F16 = false>
__device__ __forceinline__ void gemm_phase(PG8_LAS unsigned char* lds, const Gemm g, const Sched& S, const Epi& E) {
    int tid_ = ::otid();
    const int tid = tid_, wid = __builtin_amdgcn_readfirstlane(tid >> 6), lane = tid & 63, wr = wid >> 2, wc = wid & 3, fr = lane & 15, fq = lane >> 4;
    const int K = g.K, nt = K / BK;
    unsigned voffA[2], voffB[2];
#pragma unroll
    for (int i = 0; i < 2; ++i) { int R, C; stage_rc(tid * 16 + i * 8192, R, C); const int Rb = Epi::PERM ? ((R & ~31) + perm32(R & 31)) : R;
        voffA[i] = (unsigned)(R * K + C) * 2u; voffB[i] = (unsigned)(Rb * K + C) * 2u; }
    const size_t kstep = (size_t)(BK * 2);
    const size_t hstep = (size_t)HALF * K * 2;
    const size_t tstep = 2 * hstep;
    const unsigned ldsw = (unsigned)wid * 1024u;
    const int aoff = lds_byte(wr * 64 + fr, fq * 8), boff = lds_byte(wc * 32 + fr, fq * 8);
#define PG8_SA(b, h) (((b) * 2 + (h)) * HTB)
#define PG8_SB(b, h) ((4 + (b) * 2 + (h)) * HTB)
#define PG8_STAGE(bufoff, gbase, voff) do { _Pragma("unroll") for (int _i = 0; _i < 2; ++_i) \
        __builtin_amdgcn_global_load_lds((const unsigned*)((const char*)(gbase) + (voff)[_i]), (PG8_LAS unsigned*)(lds + (bufoff) + ldsw + _i * 8192), 16, 0, 0); } while (0)
#define PG8_LDA(dst, b, h) do { _Pragma("unroll") for (int m = 0; m < 4; ++m) _Pragma("unroll") for (int k = 0; k < 2; ++k) dst[m][k] = *(const PG8_LAS bf16x8*)(lds + PG8_SA(b, h) + aoff + m * 2048 + k * 1024); } while (0)
#define PG8_LDB(dst, b, h) do { _Pragma("unroll") for (int n = 0; n < 2; ++n) _Pragma("unroll") for (int k = 0; k < 2; ++k) dst[n][k] = *(const PG8_LAS bf16x8*)(lds + PG8_SB(b, h) + boff + n * 2048 + k * 1024); } while (0)
#define PG8_MMA(ai, bj, At, Bt) do { __builtin_amdgcn_s_setprio(1); _Pragma("unroll") for (int m = 0; m < 4; ++m) _Pragma("unroll") for (int n = 0; n < 2; ++n) _Pragma("unroll") for (int k = 0; k < 2; ++k) \
        acc[ai][bj][m][n] = mma16<F16>(Bt[n][k], At[m][k], acc[ai][bj][m][n]); __builtin_amdgcn_s_setprio(0); } while (0)
#define PG8_WAIT_V(n) asm volatile("s_waitcnt vmcnt(" #n ")" ::: "memory")
#define PG8_WAIT_L(n) asm volatile("s_waitcnt lgkmcnt(" #n ")" ::: "memory")
#define PG8_BAR __builtin_amdgcn_s_barrier()
#define PG8_SCHED __builtin_amdgcn_sched_barrier(0)
    Unit cur, nxt; int ui = 0;
    if (!S.next(0, cur)) return;
    f32x4 acc[2][2][4][2];
#pragma unroll
    for (int a = 0; a < 2; ++a)
#pragma unroll
        for (int b = 0; b < 2; ++b)
#pragma unroll
            for (int m = 0; m < 4; ++m)
#pragma unroll
                for (int n = 0; n < 2; ++n) acc[a][b][m][n] = (f32x4){0.f, 0.f, 0.f, 0.f};
    bf16x8 At[4][2], B0[2][2], B1[2][2];
    const char* cA = (const char*)g.A + (size_t)cur.pm * tstep; const char* cB = (const char*)g.Bt + (size_t)cur.pn * tstep;
    S.a_ready(cur);
    if constexpr (SP2) {
        PG8_STAGE(PG8_SB(0, 0), cB, voffB); PG8_STAGE(PG8_SB(0, 1), cB + hstep, voffB); PG8_STAGE(PG8_SA(0, 0), cA, voffA); PG8_STAGE(PG8_SA(0, 1), cA + hstep, voffA);
        if (wr == 1) PG8_BAR;
        PG8_WAIT_V(2); PG8_BAR;
        PG8_STAGE(PG8_SB(1, 0), cB + kstep, voffB); PG8_STAGE(PG8_SA(1, 0), cA + kstep, voffA); PG8_STAGE(PG8_SB(1, 1), cB + hstep + kstep, voffB);
        PG8_WAIT_V(6); PG8_BAR;
    } else {
        PG8_STAGE(PG8_SB(0, 0), cB, voffB); PG8_STAGE(PG8_SA(0, 0), cA, voffA); PG8_STAGE(PG8_SB(0, 1), cB + hstep, voffB); PG8_STAGE(PG8_SA(0, 1), cA + hstep, voffA);
        if (wr == 1) PG8_BAR;
        PG8_WAIT_V(4); PG8_BAR;
        PG8_STAGE(PG8_SB(1, 0), cB + kstep, voffB); PG8_STAGE(PG8_SA(1, 0), cA + kstep, voffA); PG8_STAGE(PG8_SB(1, 1), cB + hstep + kstep, voffB);
        PG8_WAIT_V(6); PG8_BAR;
    }
    for (;;) {
        const bool has_next = S.next(ui + 1, nxt);
        const char* nA = has_next ? (const char*)g.A + (size_t)nxt.pm * tstep : cA; const char* nB = has_next ? (const char*)g.Bt + (size_t)nxt.pn * tstep : cB;
        for (int t = 0; t < nt; t += 2) {
            const bool last = (t == nt - 2);
            const char* a1 = cA + (size_t)(t + 1) * kstep;
            const char* a2 = last ? nA : cA + (size_t)(t + 2) * kstep; const char* b2 = last ? nB : cB + (size_t)(t + 2) * kstep;
            const char* a3 = a2 + kstep; const char* b3 = b2 + kstep;
            if (last && has_next) S.a_ready(nxt);
            if constexpr (SP2) {
            PG8_LDB(B0, 0, 0); PG8_LDB(B1, 0, 1); PG8_SCHED; PG8_LDA(At, 0, 0); PG8_STAGE(PG8_SA(1, 1), a1 + hstep, voffA);
            PG8_WAIT_V(8); PG8_WAIT_L(0); PG8_BAR; PG8_MMA(0, 0, At, B0); PG8_MMA(0, 1, At, B1); PG8_BAR; PG8_SCHED;
            PG8_LDA(At, 0, 1); PG8_STAGE(PG8_SB(0, 0), b2, voffB); PG8_STAGE(PG8_SB(0, 1), b2 + hstep, voffB); PG8_STAGE(PG8_SA(0, 0), a2, voffA);
            PG8_WAIT_V(8); PG8_WAIT_L(0); PG8_BAR; PG8_MMA(1, 0, At, B0); PG8_MMA(1, 1, At, B1); PG8_BAR; PG8_SCHED;
            PG8_LDB(B0, 1, 0); PG8_LDB(B1, 1, 1); PG8_SCHED; PG8_LDA(At, 1, 0); PG8_STAGE(PG8_SA(0, 1), a2 + hstep, voffA);
            PG8_WAIT_V(8); PG8_WAIT_L(0); PG8_BAR; PG8_MMA(0, 0, At, B0); PG8_MMA(0, 1, At, B1); PG8_BAR; PG8_SCHED;
            PG8_LDA(At, 1, 1); PG8_STAGE(PG8_SB(1, 0), b3, voffB); PG8_STAGE(PG8_SB(1, 1), b3 + hstep, voffB); PG8_STAGE(PG8_SA(1, 0), a3, voffA);
            PG8_WAIT_V(8); PG8_WAIT_L(0); PG8_BAR; PG8_MMA(1, 0, At, B0); PG8_MMA(1, 1, At, B1); PG8_BAR; PG8_SCHED;
            } else {
            PG8_LDB(B0, 0, 0); PG8_SCHED; PG8_LDA(At, 0, 0); PG8_STAGE(PG8_SA(1, 1), a1 + hstep, voffA);
            PG8_WAIT_L(8); PG8_BAR; PG8_WAIT_L(0); PG8_MMA(0, 0, At, B0); PG8_BAR; PG8_SCHED;
            PG8_LDB(B1, 0, 1); PG8_STAGE(PG8_SB(0, 0), b2, voffB);
            PG8_BAR; PG8_WAIT_L(0); PG8_MMA(0, 1, At, B1); PG8_BAR;
            PG8_LDA(At, 0, 1); PG8_STAGE(PG8_SA(0, 0), a2, voffA);
            PG8_BAR; PG8_WAIT_L(0); PG8_MMA(1, 0, At, B0); PG8_BAR; PG8_SCHED;
            PG8_STAGE(PG8_SB(0, 1), b2 + hstep, voffB);
            PG8_WAIT_V(6); PG8_BAR; PG8_MMA(1, 1, At, B1); PG8_BAR;
            PG8_LDB(B0, 1, 0); PG8_SCHED; PG8_LDA(At, 1, 0); PG8_STAGE(PG8_SA(0, 1), a2 + hstep, voffA);
            PG8_WAIT_L(8); PG8_BAR; PG8_WAIT_L(0); PG8_MMA(0, 0, At, B0); PG8_BAR; PG8_SCHED;
            PG8_LDB(B1, 1, 1); PG8_STAGE(PG8_SB(1, 0), b3, voffB);
            PG8_BAR; PG8_WAIT_L(0); PG8_MMA(0, 1, At, B1); PG8_BAR;
            PG8_LDA(At, 1, 1); PG8_STAGE(PG8_SA(1, 0), a3, voffA);
            PG8_BAR; PG8_WAIT_L(0); PG8_MMA(1, 0, At, B0); PG8_BAR; PG8_SCHED;
            PG8_STAGE(PG8_SB(1, 1), b3 + hstep, voffB);
            PG8_WAIT_V(6); PG8_BAR; PG8_MMA(1, 1, At, B1); PG8_BAR;
            }
        }
        if constexpr (ALIGN_EPI) { if (wr == 0) PG8_BAR; }
        if constexpr (!Epi::AFTER_DRAIN) { E(acc, cur, wr, wc, fr, fq); S.done(cur); }
        if (!has_next) break;
#pragma unroll
        for (int a = 0; a < 2; ++a)
#pragma unroll
            for (int b = 0; b < 2; ++b)
#pragma unroll
                for (int m = 0; m < 4; ++m)
#pragma unroll
                    for (int n = 0; n < 2; ++n) acc[a][b][m][n] = (f32x4){0.f, 0.f, 0.f, 0.f};
        cur = nxt; cA = nA; cB = nB; ++ui;
        if constexpr (ALIGN_EPI) { if (wr == 1) PG8_BAR; }
    }
    PG8_WAIT_V(0);
    if constexpr (!ALIGN_EPI) { if (wr == 0) PG8_BAR; }
    PG8_BAR;
    if constexpr (Epi::AFTER_DRAIN) { E.fused(acc, cur, wr, wc, fr, fq, lds, wid, lane); S.done(cur); }
#undef PG8_SA
#undef PG8_SB
#undef PG8_STAGE
#undef PG8_LDA
#undef PG8_LDB
#undef PG8_MMA
#undef PG8_WAIT_V
#undef PG8_WAIT_L
#undef PG8_BAR
#undef PG8_SCHED
}
}

#define LAS __attribute__((address_space(3)))
#define DI __device__ __forceinline__
typedef unsigned short bf16;
typedef short bf16x8 __attribute__((ext_vector_type(8)));
typedef short s16x4 __attribute__((ext_vector_type(4)));
typedef float f32x2 __attribute__((ext_vector_type(2)));
typedef float f32x4 __attribute__((ext_vector_type(4)));
typedef float f32x16 __attribute__((ext_vector_type(16)));
typedef unsigned u32x4 __attribute__((ext_vector_type(4)));
typedef unsigned u32x2 __attribute__((ext_vector_type(2)));
typedef __bf16 bf16x2_t __attribute__((ext_vector_type(2)));
#define MFMA32(a, b, c) __builtin_amdgcn_mfma_f32_32x32x16_bf16((a), (b), (c), 0, 0, 0)
typedef _Float16 f16x8_t __attribute__((ext_vector_type(8)));
#define MFMA32H(a, b, c) __builtin_amdgcn_mfma_f32_32x32x16_f16(__builtin_bit_cast(f16x8_t, (a)), __builtin_bit_cast(f16x8_t, (b)), (c), 0, 0, 0)

constexpr int T = 8192, NBATCH = 2, M = NBATCH * T, D = 1024, FF = 2816, ZW = 2816, DIN = 6800, DEPTH = 2;
constexpr float LOG2E = 1.4426950408889634f, EPS = 1e-6f;
constexpr int NTHR = 512, NWAVE = 8;
constexpr int LDS_BYTES = 163840;

DI unsigned pk2(float lo, float hi) { f32x2 v = {lo, hi}; bf16x2_t b = __builtin_convertvector(v, bf16x2_t); return __builtin_bit_cast(unsigned, b); }
DI float bf2f(unsigned short v) { return __uint_as_float((unsigned)v << 16); }
DI float bflo(unsigned w) { return __uint_as_float(w << 16); }
DI float bfhi(unsigned w) { return __uint_as_float(w & 0xffff0000u); }
DI float fexp2(float x) { return __builtin_amdgcn_exp2f(x); }
DI float frcp(float x) { return __builtin_amdgcn_rcpf(x); }
DI float frsq(float x) { return __builtin_amdgcn_rsqf(x); }
DI float sigmoidf_(float x) { return frcp(1.f + fexp2(-x * LOG2E)); }
DI float gelu_tanh(float x) { const float y = 0.7978845608028654f * (x + 0.044715f * x * x * x); return x * frcp(1.f + fexp2(-2.f * LOG2E * y)); }
DI float log_sigmoid(float x) { return fminf(x, 0.f) - log1pf(__expf(-fabsf(x))); }
DI int obx() { int b = blockIdx.x; asm volatile("" : "+s"(b)); return b; }
DI int lane_id_local() { unsigned z = 0u; asm volatile("" : "+v"(z)); return (int)__builtin_amdgcn_mbcnt_hi(~0u, __builtin_amdgcn_mbcnt_lo(~0u, z)); }
DI int shx_(int v, int m) { return __builtin_amdgcn_ds_bpermute((lane_id_local() ^ m) << 2, v); }
DI float shx_(float v, int m) { return __int_as_float(__builtin_amdgcn_ds_bpermute((lane_id_local() ^ m) << 2, __float_as_int(v))); }
DI unsigned shx_(unsigned v, int m) { return (unsigned)__builtin_amdgcn_ds_bpermute((lane_id_local() ^ m) << 2, (int)v); }
DI float shup_(float v, int o) { const int l = lane_id_local(); return __int_as_float(__builtin_amdgcn_ds_bpermute((l >= o ? l - o : l) << 2, __float_as_int(v))); }
DI float h2f_(unsigned h) { const _Float16 v = __builtin_bit_cast(_Float16, (unsigned short)h); return (float)v; }
DI unsigned f2h_(float f) { const _Float16 v = (_Float16)f; return (unsigned)__builtin_bit_cast(unsigned short, v); }
DI unsigned pkh2(float a, float b) { return f2h_(a) | (f2h_(b) << 16); }
DI f32x4 unpkh4(u32x2 w) { return (f32x4){h2f_(w.x & 0xffffu), h2f_(w.x >> 16), h2f_(w.y & 0xffffu), h2f_(w.y >> 16)}; }
DI int crow(int i, int h) { return (i & 3) + 8 * (i >> 2) + 4 * h; }
DI bf16x8 pack8(float a0, float a1, float a2, float a3, float a4, float a5, float a6, float a7) {
    u32x4 p; p.x = pk2(a0, a1); p.y = pk2(a2, a3); p.z = pk2(a4, a5); p.w = pk2(a6, a7); return __builtin_bit_cast(bf16x8, p); }
DI s16x4 tr_read(LAS const char* p) { return __builtin_bit_cast(s16x4, __builtin_amdgcn_ds_read_tr16_b64_v4i16((LAS s16x4*)p)); }
DI bf16x8 cat8(s16x4 lo, s16x4 hi) { return __builtin_shufflevector(lo, hi, 0, 1, 2, 3, 4, 5, 6, 7); }

#define XB_TMO      128
#define XB_XCNT(j)  (256  + 64 * (j))
#define XB_XSUB(j)  (1280 + 64 * (j))
#define XB_XGEN(j)  (2304 + 64 * (j))
#define XB_TOP      3328
#define XB_TOPGEN   3392
#define XCD_BAR_WORDS 3456
#define XB_SPIN_CAP (1u << 18)

__device__ __forceinline__ unsigned xb_ld(unsigned* p)              { return __hip_atomic_load(p, __ATOMIC_RELAXED, __HIP_MEMORY_SCOPE_AGENT); }
__device__ __forceinline__ unsigned xb_add(unsigned* p, unsigned v) { return __hip_atomic_fetch_add(p, v, __ATOMIC_RELAXED, __HIP_MEMORY_SCOPE_AGENT); }
__device__ __forceinline__ unsigned xb_xcc_id() { return (unsigned)__builtin_amdgcn_s_getreg((3 << 11) | 20) & 0xFu; }
#define XB_SPIN(cond, bar) do { unsigned _sp = 0; while (cond) { __builtin_amdgcn_s_sleep(1); \
    if ((++_sp & 255u) == 0u) { if (xb_ld(&(bar)[XB_TMO])) break; if (_sp > XB_SPIN_CAP) { atomicAdd(&(bar)[XB_TMO], 1u); break; } } } } while (0)

struct XcdBarrier {
    unsigned* bar; unsigned x;
    volatile LAS unsigned* st;
};

__device__ __forceinline__ XcdBarrier xcd_barrier_post(unsigned* bar, volatile LAS unsigned* st) {
    XcdBarrier b; b.bar = bar; b.x = xb_xcc_id(); b.st = st;
    if (threadIdx.x == 0) (void)xb_add(&bar[XB_XCNT(b.x)], 1u);
    return b;
}
__device__ __forceinline__ void xcd_barrier_complete(unsigned* bar, unsigned x, unsigned& nloc, unsigned& nx) {
    const unsigned G = gridDim.x * gridDim.y * gridDim.z;
    unsigned sum, cnt, mine, sp = 0u;
    for (;;) {
        sum = 0u; cnt = 0u; mine = 0u;
#pragma unroll
        for (unsigned j = 0; j < 16; ++j) { const unsigned c = xb_ld(&bar[XB_XCNT(j)]); sum += c; cnt += (c > 0u) ? 1u : 0u; mine = (j == x) ? c : mine; }
        if (sum == G) break;
        __builtin_amdgcn_s_sleep(1);
        if ((++sp & 255u) == 0u) { if (xb_ld(&bar[XB_TMO])) break; if (sp > XB_SPIN_CAP) { atomicAdd(&bar[XB_TMO], 1u); break; } }
    }
    nloc = mine > 0u ? mine : 1u; nx = cnt > 0u ? cnt : 1u;
}

__device__ __forceinline__ void xcd_barrier(const XcdBarrier& b) {
    asm volatile("s_waitcnt vmcnt(0)" ::: "memory");
    __syncthreads();
    if (otid() == 0) {
        unsigned* bar = b.bar;
        __builtin_amdgcn_s_waitcnt(0);
        unsigned nloc = b.st[0], nx = b.st[1];
        if (nloc == 0u) { xcd_barrier_complete(bar, b.x, nloc, nx); b.st[0] = nloc; b.st[1] = nx; }
        const unsigned old = xb_add(&bar[XB_XSUB(b.x)], 1u);
        const unsigned gen = old / nloc;
        if (old + 1u == (gen + 1u) * nloc) {
            __builtin_amdgcn_fence(__ATOMIC_RELEASE, "agent");
            asm volatile("s_waitcnt vmcnt(0)" ::: "memory");
            const unsigned og = xb_add(&bar[XB_TOP], 1u);
            const unsigned tg = og / nx;
            if (og + 1u == (tg + 1u) * nx) xb_add(&bar[XB_TOPGEN], 1u);
            else XB_SPIN(xb_ld(&bar[XB_TOPGEN]) == tg, bar);
            __builtin_amdgcn_fence(__ATOMIC_ACQUIRE, "agent");
            xb_add(&bar[XB_XGEN(b.x)], 1u);
            asm volatile("s_waitcnt vmcnt(0)" ::: "memory");
        } else {
            XB_SPIN(xb_ld(&bar[XB_XGEN(b.x)]) == gen, bar);
            __builtin_amdgcn_fence(__ATOMIC_ACQUIRE, "agent");
            asm volatile("s_waitcnt vmcnt(0)" ::: "memory");
        }
    }
    __syncthreads();
}

constexpr size_t MiB = 1u << 20;
constexpr size_t WS_CTL = 0;
constexpr size_t WSZ_W1IN = (size_t)5632 * 1024 * 2, WSZ_W1OUT = (size_t)1024 * 2816 * 2, WSZ_WZ = (size_t)2816 * 1024 * 2, WSZ_WG = (size_t)4096 * 1024 * 2,
                 WSZ_WB = (size_t)4 * 1024 * 256 * 2, WSZ_WO = (size_t)1024 * 1024 * 2, WSZ_PHI1 = (size_t)2 * 256 * 2048 * 2;
constexpr size_t WO_W1IN = 0, WO_W1OUT = WO_W1IN + WSZ_W1IN, WO_WZ = WO_W1OUT + WSZ_W1OUT, WO_WG = WO_WZ + WSZ_WZ, WO_WB = WO_WG + WSZ_WG, WO_WO = WO_WB + WSZ_WB,
                 WO_W2IN = WO_WO + WSZ_WO, WO_W2OUT = WO_W2IN + WSZ_W1IN, WO_PHI1 = WO_W2OUT + WSZ_W1OUT, W_LAYER = WO_PHI1 + WSZ_PHI1;
constexpr size_t WS_W = 1 * MiB;
constexpr size_t WS_H = WS_W + 2 * W_LAYER;
constexpr size_t WS_BR = WS_H + (size_t)M * 1024 * 2;
constexpr size_t WS_BIG = WS_BR + (size_t)M * 1024 * 2;
constexpr size_t WS_MISC = WS_BIG + (size_t)M * 2816 * 2;
constexpr size_t WS_CUM = WS_MISC + (size_t)M * 16 * 4;
constexpr size_t WS_KC = WS_CUM + (size_t)M * 4 * 4;
constexpr size_t WS_VC = WS_KC + (size_t)2 * 512 * 64 * 2;
constexpr size_t WS_SS = WS_VC + (size_t)2 * 512 * 64 * 2;
constexpr size_t WS_END = WS_SS + (size_t)M * 16 * 4;
static_assert(W_LAYER % 256 == 0 && WS_END <= (size_t)272 * MiB, "ws map");

enum { I_X = 0, I_F1N, I_F1WI, I_F1WO, I_MIXN, I_WIN, I_DQG, I_DKG, I_DLAM, I_FQG, I_FKG, I_FBIAS, I_NQG, I_NKG, I_PE, I_PW1, I_PB1, I_PW2, I_PB2, I_GVG, I_GWS, I_GBS, I_WBR, I_WOUT, I_F2N, I_F2WI, I_F2WO, N_IN };

struct Args { const float* in[N_IN]; float* out; unsigned char* ws; };

constexpr int PTAB_OFF = 147456 + 1024;
DI unsigned long long ptab_get(LAS unsigned char* lds, int i) { unsigned a_ = (unsigned)(uintptr_t)(lds + PTAB_OFF + 8 * i); asm volatile("" : "+s"(a_)); LAS const unsigned* t = (LAS const unsigned*)(uintptr_t)a_;
    const unsigned lo = __builtin_amdgcn_readfirstlane(t[0]), hi = __builtin_amdgcn_readfirstlane(t[1]); return ((unsigned long long)hi << 32) | lo; }
#define GAS __attribute__((address_space(1)))
#define IN(i) ((const float*)(const GAS float*)ptab_get(lds, (i)))
#define OUTP ((float*)(GAS float*)ptab_get(lds, N_IN))
#define WSP ((unsigned char*)(GAS unsigned char*)ptab_get(lds, N_IN + 1))

DI float row_scale16(const float* SS, size_t row, int fq) {
    const f32x4 v = *(const f32x4*)(SS + row * 16 + 4 * fq);
    float s = (v.x + v.y) + (v.z + v.w); s += shx_(s, 16); s += shx_(s, 32);
    return frsq(s * (1.f / D) + EPS);
}
DI void row_scales8(float (&rsv)[2][4], const float* SS, size_t rowb, int fq) {
    f32x4 pv[2][4];
#pragma unroll
    for (int ai = 0; ai < 2; ++ai)
#pragma unroll
        for (int m = 0; m < 4; ++m) pv[ai][m] = *(const f32x4*)(SS + (rowb + ai * 128 + m * 16) * 16 + 4 * fq);
    asm volatile("" ::: "memory");
#pragma unroll
    for (int ai = 0; ai < 2; ++ai)
#pragma unroll
        for (int m = 0; m < 4; ++m) { const f32x4 v = pv[ai][m]; float s = (v.x + v.y) + (v.z + v.w); s += shx_(s, 16); s += shx_(s, 32); rsv[ai][m] = frsq(s * (1.f / D) + EPS); }
}
DI float row_scale_full(const float* SS, size_t row) {
    const f32x4 a = *(const f32x4*)(SS + row * 16), b = *(const f32x4*)(SS + row * 16 + 4), c = *(const f32x4*)(SS + row * 16 + 8), d = *(const f32x4*)(SS + row * 16 + 12);
    const float s = ((a.x + a.y) + (a.z + a.w)) + ((b.x + b.y) + (b.z + b.w)) + ((c.x + c.y) + (c.z + c.w)) + ((d.x + d.y) + (d.z + d.w));
    return frsq(s * (1.f / D) + EPS);
}
struct EpiSwiglu {
    static constexpr bool PERM = true, AFTER_DRAIN = false;
    LAS unsigned char* lds;
    DI void operator()(const f32x4 (&acc)[2][2][4][2], const pg8::Unit& u, int wr, int wc, int fr, int fq) const {
        bf16* O = (bf16*)(WSP + WS_BIG); const float* SS = (const float*)(WSP + WS_SS);
        const int col0 = u.pn * 128 + wc * 32 + 8 * fq;
        float rsv[2][4];
        row_scales8(rsv, SS, (size_t)u.pm * 256 + wr * 64 + fr, fq);
#pragma unroll
        for (int ai = 0; ai < 2; ++ai)
#pragma unroll
            for (int m = 0; m < 4; ++m) {
                const size_t row = (size_t)u.pm * 256 + ai * 128 + wr * 64 + m * 16 + fr;
                float o[8]; const float rs = rsv[ai][m];
#pragma unroll
                for (int n = 0; n < 2; ++n)
#pragma unroll
                    for (int e = 0; e < 4; ++e) { const float a = acc[ai][0][m][n][e] * rs, b = acc[ai][1][m][n][e] * rs; o[4 * n + e] = a * sigmoidf_(a) * b; }
                u32x4 w; w.x = pk2(o[0], o[1]); w.y = pk2(o[2], o[3]); w.z = pk2(o[4], o[5]); w.w = pk2(o[6], o[7]);
                *(u32x4*)(O + row * FF + col0) = w;
            }
    }
};
struct EpiResid {
    static constexpr bool PERM = false, AFTER_DRAIN = false;
    LAS unsigned char* lds; int src, dst; float alpha;
    DI f32x4 ld(const float* xf, const unsigned short* xh, size_t off) const { return unpkh4(*(const u32x2*)(xh + off)); }
    DI void operator()(const f32x4 (&acc)[2][2][4][2], const pg8::Unit& u, int wr, int wc, int fr, int fq) const {
        float* outf = OUTP; const float* xf = IN(I_X);
        const unsigned short* xh = (src == 2) ? (const unsigned short*)(WSP + WS_BR) : (const unsigned short*)outf;
        unsigned short* oh = (dst == 2) ? (unsigned short*)(WSP + WS_BR) : (unsigned short*)outf;
        bf16* XB = (bf16*)(WSP + WS_H); float* SS = (float*)(WSP + WS_SS);
        const int col0 = u.pn * 256 + wc * 32 + 4 * fq;
        const size_t rowb = (size_t)u.pm * 256 + wr * 64 + fr;
        f32x4 bc[2][2], bn[2][2];
#pragma unroll
        for (int bj = 0; bj < 2; ++bj)
#pragma unroll
            for (int n = 0; n < 2; ++n) bc[bj][n] = ld(xf, xh, rowb * D + col0 + bj * 128 + n * 16);
#pragma unroll
        for (int ai = 0; ai < 2; ++ai)
#pragma unroll
            for (int m = 0; m < 4; ++m) {
                const size_t row = rowb + ai * 128 + m * 16;
                if (ai * 4 + m < 7) { const size_t rown = rowb + ((ai * 4 + m + 1) >> 2) * 128 + ((ai * 4 + m + 1) & 3) * 16;
#pragma unroll
                    for (int bj = 0; bj < 2; ++bj)
#pragma unroll
                        for (int n = 0; n < 2; ++n) bn[bj][n] = ld(xf, xh, rown * D + col0 + bj * 128 + n * 16); }
                float ss = 0.f;
#pragma unroll
                for (int bj = 0; bj < 2; ++bj)
#pragma unroll
                    for (int n = 0; n < 2; ++n) { const size_t off = row * D + col0 + bj * 128 + n * 16; const f32x4 o = bc[bj][n] + acc[ai][bj][m][n] * alpha;
                        if (dst == 3) { *(f32x4*)(outf + off) = o; }
                        else { u32x2 hw; hw.x = pkh2(o.x, o.y); hw.y = pkh2(o.z, o.w); *(u32x2*)(oh + off) = hw;
                            ss += (o.x * o.x + o.y * o.y) + (o.z * o.z + o.w * o.w);
                        } }
                if (dst != 3) { ss += shx_(ss, 16); ss += shx_(ss, 32);
                    if (fq == 0) SS[row * 16 + u.pn * 4 + wc] = ss; }
#pragma unroll
                for (int bj = 0; bj < 2; ++bj)
#pragma unroll
                    for (int n = 0; n < 2; ++n) bc[bj][n] = bn[bj][n];
            }
    }
};
struct EpiZ {
    static constexpr bool PERM = true, AFTER_DRAIN = false;
    LAS unsigned char* lds; int l;
    DI void operator()(const f32x4 (&acc)[2][2][4][2], const pg8::Unit& u, int wr, int wc, int fr, int fq) const {
        bf16* Z = (bf16*)(WSP + WS_BIG); float* misc = (float*)(WSP + WS_MISC); const float* SS = (const float*)(WSP + WS_SS);
        const int pn = u.pn;
        int mode = 0; const float* gp = nullptr; float sc = 1.f;
        const float QS64 = 0.125f * LOG2E, QS32 = 0.17677669529663687f * LOG2E;
        if (pn == 0) { mode = 1; gp = IN(I_DQG) + l * 32; sc = QS32; } else if (pn == 1) { mode = 1; gp = IN(I_DKG) + l * 32; } else if (pn == 3) { mode = 2; gp = IN(I_FQG) + l * 64; sc = QS64; } else if (pn == 4) { mode = 2; gp = IN(I_FKG) + l * 64; }
        else if (pn == 6) { mode = 2; gp = IN(I_NQG) + l * 64; sc = QS64; } else if (pn == 7) { if (wc == 2) { mode = 2; gp = IN(I_NKG) + l * 64; } } else if (pn == 8) { if (wc == 0) { mode = 2; gp = IN(I_NKG) + l * 64; } else if (wc == 2) mode = 5; }
        else if (pn == 9) mode = 3; else if (pn == 10) { mode = 4; gp = IN(I_GVG) + l * 256 + 64 * wc; }
        const float* fbias = IN(I_FBIAS) + l * 4;
        float gv[2][2][4];
        {
            const float* gq = gp ? gp : IN(I_GVG);
            const int b0 = 8 * fq, b1 = (mode == 1 ? 0 : 32) + 8 * fq;
            const f32x4 g00 = *(const f32x4*)(gq + b0), g01 = *(const f32x4*)(gq + b0 + 4), g10 = *(const f32x4*)(gq + b1), g11 = *(const f32x4*)(gq + b1 + 4);
            const bool hg = (gp != nullptr);
#pragma unroll
            for (int e = 0; e < 4; ++e) { gv[0][0][e] = hg ? g00[e] * sc : 1.f; gv[0][1][e] = hg ? g01[e] * sc : 1.f; gv[1][0][e] = hg ? g10[e] * sc : 1.f; gv[1][1][e] = hg ? g11[e] * sc : 1.f; }
        }
        float rsv[2][4];
        row_scales8(rsv, SS, (size_t)u.pm * 256 + wr * 64 + fr, fq);
#pragma unroll
        for (int ai = 0; ai < 2; ++ai)
#pragma unroll
            for (int m = 0; m < 4; ++m) {
                const size_t row = (size_t)u.pm * 256 + ai * 128 + wr * 64 + m * 16 + fr;
                float v[2][2][4]; const float rs = rsv[ai][m];
#pragma unroll
                for (int bj = 0; bj < 2; ++bj)
#pragma unroll
                    for (int n = 0; n < 2; ++n)
#pragma unroll
                        for (int e = 0; e < 4; ++e) v[bj][n][e] = acc[ai][bj][m][n][e] * rs;
                if (mode == 3 || mode == 4) {
#pragma unroll
                    for (int bj = 0; bj < 2; ++bj)
#pragma unroll
                        for (int n = 0; n < 2; ++n)
#pragma unroll
                            for (int e = 0; e < 4; ++e) v[bj][n][e] = gelu_tanh(v[bj][n][e]);
                }
                if (mode == 1 || mode == 2 || mode == 4) {
                    float ss[2];
#pragma unroll
                    for (int bj = 0; bj < 2; ++bj) { float s = 0.f;
#pragma unroll
                        for (int n = 0; n < 2; ++n)
#pragma unroll
                            for (int e = 0; e < 4; ++e) s += v[bj][n][e] * v[bj][n][e];
                        s += shx_(s, 16); s += shx_(s, 32); ss[bj] = s; }
                    float r0, r1;
                    if (mode == 1) { r0 = frsq(ss[0] * (1.f / 32.f) + EPS); r1 = frsq(ss[1] * (1.f / 32.f) + EPS); }
                    else { r0 = r1 = frsq((ss[0] + ss[1]) * (1.f / 64.f) + EPS); }
#pragma unroll
                    for (int n = 0; n < 2; ++n)
#pragma unroll
                        for (int e = 0; e < 4; ++e) { v[0][n][e] *= r0 * gv[0][n][e]; v[1][n][e] *= r1 * gv[1][n][e]; }
                }
                if (mode == 5 && fq < 2) {
#pragma unroll
                    for (int n = 0; n < 2; ++n)
#pragma unroll
                        for (int e = 0; e < 4; ++e) { const int d = 8 * fq + 4 * n + e; const float x = v[0][n][e];
                            misc[row * 16 + d] = (d < 4) ? log_sigmoid(x + fbias[d & 3]) : sigmoidf_(x); }
                }
#pragma unroll
                for (int bj = 0; bj < 2; ++bj) { u32x4 w; w.x = pk2(v[bj][0][0], v[bj][0][1]); w.y = pk2(v[bj][0][2], v[bj][0][3]); w.z = pk2(v[bj][1][0], v[bj][1][1]); w.w = pk2(v[bj][1][2], v[bj][1][3]);
                    *(u32x4*)(Z + row * ZW + pn * 256 + wc * 64 + bj * 32 + 8 * fq) = w; }
            }
    }
};

DI int map_ffn_in(int r) { const int t = r >> 8, w = r & 255; return (w < 128) ? 128 * t + w : FF + 128 * t + (w - 128); }
DI int map_z(int r) {
    const int c = (r & ~255) + 64 * ((r >> 5) & 3) + 32 * ((r >> 7) & 1) + (r & 31);
    if (c < 1536) return c;
    if (c < 1792) return 1540 + (c - 1536);
    if (c < 2176) return 1796 + (c - 1792);
    if (c < 2180) return 1536 + (c - 2176);
    if (c < 2192) return c;
    if (c < 2304) return -1;
    if (c < 2560) return 2192 + (c - 2304);
    return 2448 + (c - 2560);
}
DI void conv_matrix(int MAP, const float* W, int pitch, int K, int rows, bf16* WT, LAS float* scr, int gw, int ngw, const float* gain, bool f16) {
    const int lane = otid() & 63;
    const int nblk = rows / 32, nitems = (K / 64) * nblk;
    const int q4 = lane & 7, kk0 = lane >> 3, c = lane & 7;
#define CV_LOAD(dst, item) do { const int kb_ = (item) / nblk, nb_ = (item) % nblk; const int rq_ = 32 * nb_ + 4 * q4; int sq_; \
        if (MAP == 0) sq_ = rq_; else if (MAP == 1) sq_ = map_ffn_in(rq_); else if (MAP == 2) sq_ = map_z(rq_); else sq_ = 2704 + rq_; \
        _Pragma("unroll") for (int i_ = 0; i_ < 8; ++i_) dst[i_] = (sq_ >= 0) ? *(const f32x4*)(W + (size_t)(64 * kb_ + kk0 + 8 * i_) * pitch + sq_) : (f32x4){0.f, 0.f, 0.f, 0.f}; } while (0)
    f32x4 v[8], vn[8];
    int it = gw;
    if (it < nitems) CV_LOAD(v, it);
    while (it < nitems) {
        const int nx = it + ngw;
        if (nx < nitems) CV_LOAD(vn, nx);
        const int kb = it / nblk, nb = it % nblk, k0 = 64 * kb, r0 = 32 * nb;
#pragma unroll
        for (int i = 0; i < 8; ++i) { const float gk = gain ? gain[k0 + kk0 + 8 * i] : 1.f; LAS float* d = scr + (kk0 + 8 * i) * 33 + 4 * q4; d[0] = v[i].x * gk; d[1] = v[i].y * gk; d[2] = v[i].z * gk; d[3] = v[i].w * gk; }
        asm volatile("s_waitcnt lgkmcnt(0)" ::: "memory");
#pragma unroll
        for (int j = 0; j < 4; ++j) { const int n = (lane >> 3) + 8 * j; const LAS float* s = scr + (8 * c) * 33 + n;
            u32x4 o; if (f16) { o.x = pkh2(s[0 * 33], s[1 * 33]); o.y = pkh2(s[2 * 33], s[3 * 33]); o.z = pkh2(s[4 * 33], s[5 * 33]); o.w = pkh2(s[6 * 33], s[7 * 33]); }
            else { o.x = pk2(s[0 * 33], s[1 * 33]); o.y = pk2(s[2 * 33], s[3 * 33]); o.z = pk2(s[4 * 33], s[5 * 33]); o.w = pk2(s[6 * 33], s[7 * 33]); }
            *(u32x4*)(WT + (size_t)(r0 + n) * K + k0 + 8 * c) = o; }
        asm volatile("s_waitcnt lgkmcnt(0)" ::: "memory");
#pragma unroll
        for (int i = 0; i < 8; ++i) v[i] = vn[i];
        it = nx;
    }
#undef CV_LOAD
}
DI float wave_sum(float v) {
#pragma unroll
    for (int o = 1; o < 64; o <<= 1) v += shx_(v, o);
    return v;
}
DI void cast_rows(const float* x, bf16* XB, float* SS, unsigned short* XH, int gw, int ngw) {
    const int lane = otid() & 63;
    for (int m = gw; m < M; m += ngw) {
        const f32x4* xr = (const f32x4*)(x + (size_t)m * D) + lane;
        f32x4 v[4]; float s = 0.f;
#pragma unroll
        for (int j = 0; j < 4; ++j) { v[j] = xr[64 * j]; s += (v[j].x * v[j].x + v[j].y * v[j].y) + (v[j].z * v[j].z + v[j].w * v[j].w); }
        s = wave_sum(s);
        u32x2* h8 = (u32x2*)(XH + (size_t)m * D) + lane;
#pragma unroll
        for (int j = 0; j < 4; ++j) { u32x2 w; w.x = pkh2(v[j].x, v[j].y); w.y = pkh2(v[j].z, v[j].w); h8[64 * j] = w; }
        if (lane < 16) SS[(size_t)m * 16 + lane] = (lane == 0) ? s : 0.f;
    }
}

constexpr int TROW = 144, TILEB = 64 * TROW;
constexpr int L_KB = 0, L_VB = 2 * TILEB, L_CB = 4 * TILEB, L_IMP = L_CB + 512, L_SEL = L_IMP + 64 * 128 * 4, L_Q = L_SEL + 1024, L_END = L_Q + 64;

struct Soft { float m, l; f32x16 o0, o1; };
DI void soft_init(Soft& s) { s.m = 0.f; s.l = 0.f;
#pragma unroll
    for (int i = 0; i < 16; ++i) { s.o0[i] = 0.f; s.o1[i] = 0.f; } }
DI f32x16 qk_tile(LAS const char* Kt, const bf16x8* qf, int d0, int nd, int r, int h, float cinit) {
    f32x16 s;
#pragma unroll
    for (int i = 0; i < 16; ++i) s[i] = cinit;
#pragma unroll
    for (int ds = 0; ds < 4; ++ds) if (ds >= d0 && ds < d0 + nd) {
        const bf16x8 a = *(LAS const bf16x8*)(Kt + r * TROW + ds * 32 + h * 16);
        s = MFMA32(a, qf[ds], s);
    }
    return s;
}
template <int D0, int ND> DI void qk_pair(f32x16& s0, f32x16& s1, LAS const char* Kt, const bf16x8* qf, int r, int h, float cinit) {
    bf16x8 ka[ND], kb[ND];
#pragma unroll
    for (int ds = 0; ds < ND; ++ds) { ka[ds] = *(LAS const bf16x8*)(Kt + r * TROW + (D0 + ds) * 32 + h * 16); kb[ds] = *(LAS const bf16x8*)(Kt + (32 + r) * TROW + (D0 + ds) * 32 + h * 16); }
    asm volatile("" ::: "memory");
#pragma unroll
    for (int i = 0; i < 16; ++i) { s0[i] = cinit; s1[i] = cinit; }
#pragma unroll
    for (int ds = 0; ds < ND; ++ds) { s0 = MFMA32(ka[ds], qf[D0 + ds], s0); s1 = MFMA32(kb[ds], qf[D0 + ds], s1); }
}
constexpr float SOFT_THR = 6.0f;
template <bool TRACK = true> DI void soft_pre(Soft& st, f32x16& s0, f32x16& s1, bf16x8* p) {
  if (TRACK) {
    float ra = fmaxf(fmaxf(s0[0], s0[1]), s1[0]), rb = fmaxf(fmaxf(s0[2], s0[3]), s1[1]);
    ra = fmaxf(fmaxf(ra, s1[2]), s1[3]);
#pragma unroll
    for (int i = 4; i < 16; i += 4) { ra = fmaxf(fmaxf(ra, s0[i]), s0[i + 1]); rb = fmaxf(fmaxf(rb, s0[i + 2]), s0[i + 3]); ra = fmaxf(fmaxf(ra, s1[i]), s1[i + 1]); rb = fmaxf(fmaxf(rb, s1[i + 2]), s1[i + 3]); }
    float rm = fmaxf(ra, rb);
    rm = fmaxf(rm, shx_(rm, 32));
    if (__any(rm > SOFT_THR)) {
        const float d = fmaxf(rm, 0.f), f = fexp2(-d);
        st.m += d; st.l *= f;
        s0 = s0 - d; s1 = s1 - d; st.o0 = st.o0 * f; st.o1 = st.o1 * f;
    }
  }
#pragma unroll
    for (int i = 0; i < 16; ++i) { s0[i] = fexp2(s0[i]); s1[i] = fexp2(s1[i]); }
    {
        f32x16 t = s0 + s1;
        const float a0 = (t[0] + t[1]) + (t[2] + t[3]), a1 = (t[4] + t[5]) + (t[6] + t[7]), a2 = (t[8] + t[9]) + (t[10] + t[11]), a3 = (t[12] + t[13]) + (t[14] + t[15]);
        st.l += (a0 + a1) + (a2 + a3);
    }
    p[0] = pack8(s0[0], s0[1], s0[2], s0[3], s0[4], s0[5], s0[6], s0[7]);
    p[1] = pack8(s0[8], s0[9], s0[10], s0[11], s0[12], s0[13], s0[14], s0[15]);
    p[2] = pack8(s1[0], s1[1], s1[2], s1[3], s1[4], s1[5], s1[6], s1[7]);
    p[3] = pack8(s1[8], s1[9], s1[10], s1[11], s1[12], s1[13], s1[14], s1[15]);
}
DI void soft_step(Soft& st, f32x16& s0, f32x16& s1, LAS const char* Vt, int lane) {
    const int g = (lane >> 4) & 1, h = lane >> 5, q = (lane & 15) >> 2, pp = lane & 3;
    LAS const char* vb = Vt + (4 * h + q) * TROW + (16 * g + 4 * pp) * 2;
    bf16x8 va[2], vbq[2];
#pragma unroll
    for (int ks = 0; ks < 2; ++ks) { va[ks] = cat8(tr_read(vb + (16 * ks) * TROW), tr_read(vb + (16 * ks + 8) * TROW)); vbq[ks] = cat8(tr_read(vb + (16 * ks) * TROW + 64), tr_read(vb + (16 * ks + 8) * TROW + 64)); }
    asm volatile("" ::: "memory");
    bf16x8 p[4]; soft_pre(st, s0, s1, p);
    bf16x8 vc[2], vd[2];
#pragma unroll
    for (int ks = 2; ks < 4; ++ks) { vc[ks - 2] = cat8(tr_read(vb + (16 * ks) * TROW), tr_read(vb + (16 * ks + 8) * TROW)); vd[ks - 2] = cat8(tr_read(vb + (16 * ks) * TROW + 64), tr_read(vb + (16 * ks + 8) * TROW + 64)); }
    asm volatile("" ::: "memory");
#pragma unroll
    for (int ks = 0; ks < 2; ++ks) { st.o0 = MFMA32(va[ks], p[ks], st.o0); st.o1 = MFMA32(vbq[ks], p[ks], st.o1); }
#pragma unroll
    for (int ks = 0; ks < 2; ++ks) { st.o0 = MFMA32(vc[ks], p[2 + ks], st.o0); st.o1 = MFMA32(vd[ks], p[2 + ks], st.o1); }
}
DI void pv_step2(Soft& sa, Soft& sb, const bf16x8* pa, const bf16x8* pb, LAS const char* Vt, int lane) {
    const int g = (lane >> 4) & 1, h = lane >> 5, q = (lane & 15) >> 2, pp = lane & 3;
    LAS const char* vb = Vt + (4 * h + q) * TROW + (16 * g + 4 * pp) * 2;
#pragma unroll
    for (int ks = 0; ks < 4; ++ks) {
        const bf16x8 v0 = cat8(tr_read(vb + (16 * ks) * TROW), tr_read(vb + (16 * ks + 8) * TROW));
        const bf16x8 v1 = cat8(tr_read(vb + (16 * ks) * TROW + 64), tr_read(vb + (16 * ks + 8) * TROW + 64));
        sa.o0 = MFMA32(v0, pa[ks], sa.o0); sa.o1 = MFMA32(v1, pa[ks], sa.o1);
        sb.o0 = MFMA32(v0, pb[ks], sb.o0); sb.o1 = MFMA32(v1, pb[ks], sb.o1);
    }
}
DI float gain_max(const float* g, int n) { float m = 0.f; for (int d = 0; d < n; ++d) m = fmaxf(m, fabsf(g[d])); return m; }
DI u32x4 tile_ld(const bf16* src, int pitch, int tid) { return *(const u32x4*)(src + (size_t)(tid >> 3) * pitch + (tid & 7) * 8); }
DI void tile_st(LAS char* dst, u32x4 v, int tid) { *(LAS u32x4*)(dst + (tid >> 3) * TROW + (tid & 7) * 16) = v; }

DI void store_o(bf16* dst, const f32x16& o0, const f32x16& o1, float sc, int h) {
#pragma unroll
    for (int g = 0; g < 4; ++g) {
        u32x2 w0, w1; w0.x = pk2(o0[4 * g] * sc, o0[4 * g + 1] * sc); w0.y = pk2(o0[4 * g + 2] * sc, o0[4 * g + 3] * sc);
        w1.x = pk2(o1[4 * g] * sc, o1[4 * g + 1] * sc); w1.y = pk2(o1[4 * g + 2] * sc, o1[4 * g + 3] * sc);
        *(u32x2*)(dst + 8 * g + 4 * h) = w0; *(u32x2*)(dst + 32 + 8 * g + 4 * h) = w1;
    }
}

template <bool DIFF, bool TRACK = true> DI void attn_unit(int b, int hd, int qb, const bf16* Z, const float* CUM, bf16* BR, float lam, float lam_init, const float* kgain, LAS char* lds) {
    const int tid = otid(), lane = tid & 63, wid = tid >> 6, r = lane & 31, h = lane >> 5;
    const size_t rb = (size_t)b * T;
    const int q0 = qb * 256, qrow = q0 + wid * 32 + r;
    const int qcol = (DIFF ? 0 : 768) + hd * 64, kcol = (DIFF ? 256 : 1024) + hd * 64, vcol = (DIFF ? 512 : 1280) + hd * 64;
    bf16x8 qf[4];
#pragma unroll
    for (int ds = 0; ds < 4; ++ds) qf[ds] = *(const bf16x8*)(Z + (rb + qrow) * ZW + qcol + ds * 16 + h * 8);
    float cq = 0.f, thr_max = 0.f;
    if (!DIFF) {
        cq = CUM[(rb + qrow) * 4 + hd] * LOG2E;
        float gmax = 0.f; for (int d = 0; d < 64; ++d) gmax = fmaxf(gmax, fabsf(kgain[d]));
        float qn = 0.f;
#pragma unroll
        for (int ds = 0; ds < 4; ++ds) { const u32x4 w = __builtin_bit_cast(u32x4, qf[ds]);
            qn += bflo(w.x) * bflo(w.x) + bfhi(w.x) * bfhi(w.x) + bflo(w.y) * bflo(w.y) + bfhi(w.y) * bfhi(w.y) + bflo(w.z) * bflo(w.z) + bfhi(w.z) * bfhi(w.z) + bflo(w.w) * bflo(w.w) + bfhi(w.w) * bfhi(w.w); }
        qn += shx_(qn, 32);
        const float B = sqrtf(qn) * 8.08f * gmax;
        float thr = cq + 2.f * B + 48.f;
#pragma unroll
        for (int o = 1; o < 64; o <<= 1) thr = fmaxf(thr, shx_(thr, o));
        LAS float* wt = (LAS float*)(lds + L_Q + 16);
        if (lane == 0) wt[wid] = thr;
        __syncthreads();
        thr_max = wt[0];
#pragma unroll
        for (int w = 1; w < 8; ++w) thr_max = fmaxf(thr_max, wt[w]);
    }
    Soft s1, s2; soft_init(s1); if (DIFF) soft_init(s2);
    const int nt = (q0 + 256) / 64;
    const bf16* Kg = Z + rb * ZW + kcol; const bf16* Vg = Z + rb * ZW + vcol;
    u32x4 kr = tile_ld(Kg + (size_t)(nt - 1) * 64 * ZW, ZW, tid), vr = tile_ld(Vg + (size_t)(nt - 1) * 64 * ZW, ZW, tid); float cr = 0.f;
    if (!DIFF && tid < 64) cr = CUM[(rb + (nt - 1) * 64 + tid) * 4 + hd] * LOG2E;
    for (int it = 0; it < nt; ++it) {
        const int kt = nt - 1 - it, buf = it & 1;
        LAS char* Kt = lds + L_KB + buf * TILEB; LAS char* Vt = lds + L_VB + buf * TILEB; LAS float* cb = (LAS float*)(lds + L_CB) + buf * 64;
        tile_st(Kt, kr, tid); tile_st(Vt, vr, tid); if (!DIFF && tid < 64) cb[tid] = cr;
        __syncthreads();
        if (!DIFF) { if (cb[63] > thr_max) break; }
        if (kt > 0) { kr = tile_ld(Kg + (size_t)(kt - 1) * 64 * ZW, ZW, tid); vr = tile_ld(Vg + (size_t)(kt - 1) * 64 * ZW, ZW, tid); if (!DIFF && tid < 64) cr = CUM[(rb + (kt - 1) * 64 + tid) * 4 + hd] * LOG2E; }
        const bool diag = (kt * 64 + 63 > q0 + wid * 32);
        if (kt * 64 > q0 + wid * 32 + 31) continue;
        if (DIFF) {
            bf16x8 p1[4], p2[4];
#pragma unroll
            for (int mp = 0; mp < 2; ++mp) {
                const float ci = -(mp == 0 ? s1.m : s2.m);
                f32x16 a0, a1; if (mp == 0) qk_pair<0, 2>(a0, a1, Kt, qf, r, h, ci); else qk_pair<2, 2>(a0, a1, Kt, qf, r, h, ci);
                if (diag) {
#pragma unroll
                    for (int i = 0; i < 16; ++i) { const int key = kt * 64 + crow(i, h); if (key > qrow) a0[i] = -INFINITY; if (key + 32 > qrow) a1[i] = -INFINITY; }
                }
                soft_pre<TRACK>(mp == 0 ? s1 : s2, a0, a1, mp == 0 ? p1 : p2);
            }
            pv_step2(s1, s2, p1, p2, Vt, lane);
        } else {
            const float ci = cq - s1.m;
            f32x16 a0, a1; qk_pair<0, 4>(a0, a1, Kt, qf, r, h, ci);
#pragma unroll
            for (int g = 0; g < 4; ++g) { const f32x4 c0 = *(LAS const f32x4*)(cb + 8 * g + 4 * h), c1 = *(LAS const f32x4*)(cb + 32 + 8 * g + 4 * h);
#pragma unroll
                for (int e = 0; e < 4; ++e) { a0[4 * g + e] -= c0[e]; a1[4 * g + e] -= c1[e]; } }
            if (diag) {
#pragma unroll
                for (int i = 0; i < 16; ++i) { const int key = kt * 64 + crow(i, h); if (key > qrow) a0[i] = -INFINITY; if (key + 32 > qrow) a1[i] = -INFINITY; }
            }
            soft_step(s1, a0, a1, Vt, lane);
        }
    }
    float l1 = s1.l + shx_(s1.l, 32); const float i1 = 1.f / fmaxf(l1, 1e-30f);
    if (DIFF) {
        float l2 = s2.l + shx_(s2.l, 32); const float i2 = lam / fmaxf(l2, 1e-30f);
        float ss = 0.f;
#pragma unroll
        for (int i = 0; i < 16; ++i) { s1.o0[i] = s1.o0[i] * i1 - s2.o0[i] * i2; s1.o1[i] = s1.o1[i] * i1 - s2.o1[i] * i2; ss += s1.o0[i] * s1.o0[i] + s1.o1[i] * s1.o1[i]; }
        ss += shx_(ss, 32);
        const float rr = frsq(ss * (1.f / 64.f) + EPS) * (1.f - lam_init);
        store_o(BR + (rb + qrow) * 1024 + hd * 64, s1.o0, s1.o1, rr, h);
    } else {
        store_o(BR + (rb + qrow) * 1024 + 256 + hd * 64, s1.o0, s1.o1, i1, h);
    }
    __syncthreads();
}

template <int MODE> DI void nsa_loop(Soft& st, const bf16x8* qf, const bf16* Kg, const bf16* Vg, int pitch, int j0, int j1, int tq, int t0, LAS const unsigned* bm, LAS char* lds) {
    const int tid = otid(), lane = tid & 63, r = lane & 31, h = lane >> 5;
    u32x4 kr = tile_ld(Kg + (size_t)j0 * 64 * pitch, pitch, tid), vr = tile_ld(Vg + (size_t)j0 * 64 * pitch, pitch, tid);
    for (int j = j0; j <= j1; ++j) {
        const int buf = (j - j0) & 1;
        LAS char* Kt = lds + L_KB + buf * TILEB; LAS char* Vt = lds + L_VB + buf * TILEB;
        tile_st(Kt, kr, tid); tile_st(Vt, vr, tid);
        __syncthreads();
        if (j < j1) { kr = tile_ld(Kg + (size_t)(j + 1) * 64 * pitch, pitch, tid); vr = tile_ld(Vg + (size_t)(j + 1) * 64 * pitch, pitch, tid); }
        float ci = -st.m; bool need_mask;
        if (MODE == 1) { const bool sel = (bm[j >> 5] >> (j & 31)) & 1u; if (!__any(sel)) continue;
            if (!sel) ci = -INFINITY; need_mask = (j == j1); }
        else if (MODE == 0) need_mask = (16 * (j * 64 + 63) + 31 > t0);
        else need_mask = (j == j1) || (j + 8 == j1);
        f32x16 a0, a1; qk_pair<0, 4>(a0, a1, Kt, qf, r, h, ci);
        if (need_mask) {
            if (MODE == 0) {
#pragma unroll
                for (int i = 0; i < 16; ++i) { const int n = j * 64 + crow(i, h); if (16 * n + 31 > tq) a0[i] = -INFINITY; if (16 * (n + 32) + 31 > tq) a1[i] = -INFINITY; }
            } else if (MODE == 1) {
#pragma unroll
                for (int i = 0; i < 16; ++i) { const int key = j * 64 + crow(i, h); if (key > tq) a0[i] = -INFINITY; if (key + 32 > tq) a1[i] = -INFINITY; }
            } else {
#pragma unroll
                for (int i = 0; i < 16; ++i) { const int key = j * 64 + crow(i, h); if (key > tq || key < tq - 511) a0[i] = -INFINITY; if (key + 32 > tq || key + 32 < tq - 511) a1[i] = -INFINITY; }
            }
        }
        soft_step(st, a0, a1, Vt, lane);
    }
    __syncthreads();
}
DI void nsa_unit(int b, int cur, const bf16* Z, const bf16* KC, const bf16* VC, const float* MISC, bf16* BR, LAS char* lds) {
    const int tid = otid(), lane = tid & 63, wid = tid >> 6, r = lane & 31, h = lane >> 5;
    const size_t rb = (size_t)b * T;
    const int t0 = cur * 64, ql = wid * 8 + (r >> 2), tq = t0 + ql, hd = r & 3;
    bf16x8 qf[4];
#pragma unroll
    for (int ds = 0; ds < 4; ++ds) qf[ds] = *(const bf16x8*)(Z + (rb + tq) * ZW + 1536 + hd * 64 + ds * 16 + h * 8);
    LAS float* imp = (LAS float*)(lds + L_IMP);
    for (int i = tid; i < 64 * 128; i += NTHR) imp[i] = 0.f;
    float oc0[16], oc1[16];
    const float g0 = MISC[(rb + tq) * 16 + 4 + hd * 3 + 0], g1 = MISC[(rb + tq) * 16 + 4 + hd * 3 + 1], g2 = MISC[(rb + tq) * 16 + 4 + hd * 3 + 2];
    const bf16* KCb = KC + (size_t)b * 512 * 64; const bf16* VCb = VC + (size_t)b * 512 * 64;
    const int ncmp = (cur >= 1 || true) ? (4 * cur + 3) : 0;
    const int jc1 = (ncmp - 1) / 64;
    Soft sc; soft_init(sc);
    nsa_loop<0>(sc, qf, KCb, VCb, 64, 0, jc1, tq, t0, nullptr, lds);
    const float lc = sc.l + shx_(sc.l, 32); const float ilc = 1.f / fmaxf(lc, 1e-30f);
#pragma unroll
    for (int i = 0; i < 16; ++i) { oc0[i] = sc.o0[i] * ilc * g0; oc1[i] = sc.o1[i] * ilc * g0; }
    {
        const float mfin = sc.m;
        u32x4 kr = tile_ld(KCb, 64, tid);
        for (int j = 0; j <= jc1; ++j) {
            const int buf = j & 1; LAS char* Kt = lds + L_KB + buf * TILEB;
            tile_st(Kt, kr, tid);
            __syncthreads();
            if (j < jc1) kr = tile_ld(KCb + (size_t)(j + 1) * 64 * 64, 64, tid);
#pragma unroll
            for (int half = 0; half < 2; ++half) {
                f32x16 a = qk_tile(Kt + half * 32 * TROW, qf, 0, 4, r, h, -mfin);
#pragma unroll
                for (int g = 0; g < 4; ++g) {
                    float pv[4];
#pragma unroll
                    for (int e = 0; e < 4; ++e) { const int n = j * 64 + half * 32 + 8 * g + 4 * h + e; pv[e] = (16 * n + 31 > tq) ? 0.f : fexp2(a[4 * g + e]) * ilc; }
                    float G = (pv[0] + pv[1]) + (pv[2] + pv[3]), L = pv[3];
                    G += shx_(G, 1); G += shx_(G, 2); L += shx_(L, 1); L += shx_(L, 2);
                    const int jb = j * 16 + half * 8 + 2 * g + h;
                    if (hd == 0) { if (jb < 128) __hip_atomic_fetch_add(&imp[ql * 128 + jb], G, __ATOMIC_RELAXED, __HIP_MEMORY_SCOPE_WORKGROUP); if (jb + 1 < 128) __hip_atomic_fetch_add(&imp[ql * 128 + jb + 1], L, __ATOMIC_RELAXED, __HIP_MEMORY_SCOPE_WORKGROUP); }
                }
            }
        }
        __syncthreads();
    }
    LAS unsigned* selm = (LAS unsigned*)(lds + L_SEL);
    {
        const int qi = lane >> 3, sub = lane & 7, qq = wid * 8 + qi, t = t0 + qq;
        LAS unsigned* kp = (LAS unsigned*)imp + qq * 128 + sub * 16;
#pragma unroll
        for (int c4 = 0; c4 < 4; ++c4) {
            const f32x4 v = *(LAS const f32x4*)((LAS const float*)kp + 4 * c4); u32x4 k;
#pragma unroll
            for (int e = 0; e < 4; ++e) { const int j = sub * 16 + 4 * c4 + e; const bool forced = (j == 0) || (j == cur) || (j == cur - 1); const bool valid = (j * 64 <= t);
                const float x = forced ? 1.0e4f : v[e]; k[e] = (forced || valid) ? (__float_as_uint(fmaxf(x, 0.f)) + 1u) : 0u; }
            *(LAS u32x4*)(kp + 4 * c4) = k;
        }
        unsigned bm0 = 0, bm1 = 0, bm2 = 0, bm3 = 0;
        for (int it = 0; it < 16; ++it) {
            unsigned bu = 0; int bj = 0;
#pragma unroll
            for (int c4 = 0; c4 < 4; ++c4) { const u32x4 k = *(LAS const u32x4*)(kp + 4 * c4);
#pragma unroll
                for (int e = 0; e < 4; ++e) if (k[e] > bu) { bu = k[e]; bj = sub * 16 + 4 * c4 + e; } }
#pragma unroll
            for (int o = 1; o < 8; o <<= 1) { const unsigned ou = shx_(bu, o); const int oj = shx_(bj, o); if (ou > bu || (ou == bu && oj < bj)) { bu = ou; bj = oj; } }
            if (bu != 0u) {
                if ((bj >> 4) == sub) ((LAS unsigned*)imp)[qq * 128 + bj] = 0u;
                const unsigned bit = 1u << (bj & 31);
                if (bj < 32) bm0 |= bit; else if (bj < 64) bm1 |= bit; else if (bj < 96) bm2 |= bit; else bm3 |= bit;
            }
        }
        if (sub == 0) { selm[qq * 4 + 0] = bm0; selm[qq * 4 + 1] = bm1; selm[qq * 4 + 2] = bm2; selm[qq * 4 + 3] = bm3; }
    }
    __syncthreads();
    LAS const unsigned* bm = selm + ql * 4;
    {
        Soft ss; soft_init(ss);
        nsa_loop<1>(ss, qf, Z + rb * ZW + 1920, Z + rb * ZW + 1984, ZW, 0, cur, tq, t0, bm, lds);
        const float l = ss.l + shx_(ss.l, 32); const float il = g1 / fmaxf(l, 1e-30f);
#pragma unroll
        for (int i = 0; i < 16; ++i) { oc0[i] += ss.o0[i] * il; oc1[i] += ss.o1[i] * il; }
    }
    {
        Soft sw; soft_init(sw);
        const int jw0 = cur >= 8 ? cur - 8 : 0;
        nsa_loop<2>(sw, qf, Z + rb * ZW + 2048, Z + rb * ZW + 2112, ZW, jw0, cur, tq, t0, nullptr, lds);
        const float l = sw.l + shx_(sw.l, 32); const float il = g2 / fmaxf(l, 1e-30f);
#pragma unroll
        for (int i = 0; i < 16; ++i) { oc0[i] += sw.o0[i] * il; oc1[i] += sw.o1[i] * il; }
    }
    {
        bf16* dst = BR + (rb + tq) * 1024 + 512 + hd * 64;
#pragma unroll
        for (int g = 0; g < 4; ++g) {
            u32x2 w0, w1; w0.x = pk2(oc0[4 * g], oc0[4 * g + 1]); w0.y = pk2(oc0[4 * g + 2], oc0[4 * g + 3]);
            w1.x = pk2(oc1[4 * g], oc1[4 * g + 1]); w1.y = pk2(oc1[4 * g + 2], oc1[4 * g + 3]);
            *(u32x2*)(dst + 8 * g + 4 * h) = w0; *(u32x2*)(dst + 32 + 8 * g + 4 * h) = w1;
        }
    }
    __syncthreads();
}

DI void gmlp_unit(int b, int ch, int g, int l, const bf16* Z, const float* WS_, const float* BS_, bf16* BR, LAS char* lds) {
    const int tid = otid(), lane = tid & 63, wid = tid >> 6, r = lane & 31, h = lane >> 5;
    const size_t row0 = (size_t)b * T + ch * 128;
    const bf16* Vg = Z + row0 * ZW + 2560 + 64 * g;
    const int dt = wid & 1, tt = wid >> 1, t = 32 * tt + r;
    const float* Wr = WS_ + ((size_t)(l * 4 + g) * 128 + t) * 128;
    u32x4 vst[2];
#pragma unroll
    for (int u = 0; u < 2; ++u) { const int c = tid + 512 * u; vst[u] = *(const u32x4*)(Vg + (size_t)(c >> 3) * ZW + (c & 7) * 8); }
    const int nk = (32 * tt + 31) / 16 + 1;
    f32x4 wl0[8], wl1[8];
#pragma unroll
    for (int ks = 0; ks < 8; ++ks) if (ks < nk) { wl0[ks] = *(const f32x4*)(Wr + 16 * ks + 8 * h); wl1[ks] = *(const f32x4*)(Wr + 16 * ks + 8 * h + 4); }
    const float bias = BS_[(size_t)(l * 4 + g) * 128 + t];
    const bf16* ug = Z + (row0 + t) * ZW + 2304 + 64 * g + 32 * dt;
    u32x2 uu[4];
#pragma unroll
    for (int k = 0; k < 4; ++k) uu[k] = *(const u32x2*)(ug + 8 * k + 4 * h);
#pragma unroll
    for (int u = 0; u < 2; ++u) { const int c = tid + 512 * u; *(LAS u32x4*)(lds + (c >> 3) * TROW + (c & 7) * 16) = vst[u]; }
    __syncthreads();
    f32x16 acc;
#pragma unroll
    for (int i = 0; i < 16; ++i) acc[i] = 0.f;
    const int gg = (lane >> 4) & 1, q = (lane & 15) >> 2, pp = lane & 3;
    LAS const char* vb = lds + (8 * h + q) * TROW + (32 * dt + 16 * gg + 4 * pp) * 2;
#pragma unroll
    for (int ks = 0; ks < 8; ++ks) if (ks < nk) {
        const bf16x8 a = cat8(tr_read(vb + (16 * ks) * TROW), tr_read(vb + (16 * ks + 4) * TROW));
        float wv[8] = {wl0[ks].x, wl0[ks].y, wl0[ks].z, wl0[ks].w, wl1[ks].x, wl1[ks].y, wl1[ks].z, wl1[ks].w};
#pragma unroll
        for (int j = 0; j < 8; ++j) if (16 * ks + 8 * h + j > t) wv[j] = 0.f;
        const bf16x8 bb = pack8(wv[0], wv[1], wv[2], wv[3], wv[4], wv[5], wv[6], wv[7]);
        acc = MFMA32(a, bb, acc);
    }
    bf16* dst = BR + (row0 + t) * 1024 + 768 + 64 * g + 32 * dt;
#pragma unroll
    for (int k = 0; k < 4; ++k) {
        u32x2 w; w.x = pk2(bflo(uu[k].x) * (acc[4 * k] + bias), bfhi(uu[k].x) * (acc[4 * k + 1] + bias)); w.y = pk2(bflo(uu[k].y) * (acc[4 * k + 2] + bias), bfhi(uu[k].y) * (acc[4 * k + 3] + bias));
        *(u32x2*)(dst + 8 * k + 4 * h) = w;
    }
    __syncthreads();
}

DI void cumsum_unit(int b, int hd, const float* MISC, float* CUM, LAS char* lds) {
    const int tid = otid(), lane = tid & 63, wid = tid >> 6;
    const size_t rb = (size_t)b * T;
    float v[16]; float run = 0.f;
#pragma unroll
    for (int j = 0; j < 16; ++j) { run += MISC[(rb + tid * 16 + j) * 16 + hd]; v[j] = run; }
    float inc = run;
#pragma unroll
    for (int o = 1; o < 64; o <<= 1) { const float n = shup_(inc, o); if (lane >= o) inc += n; }
    LAS float* wt = (LAS float*)lds;
    if (lane == 63) wt[wid] = inc;
    __syncthreads();
    float off = inc - run;
    for (int w = 0; w < wid; ++w) off += wt[w];
#pragma unroll
    for (int j = 0; j < 16; ++j) CUM[(rb + tid * 16 + j) * 4 + hd] = v[j] + off;
    __syncthreads();
}

DI void compress_unit(int l, int s, int b, int nb, const bf16* Z, const bf16* phi1t, const float* pe, const float* b1, const float* w2, const float* b2, const float* nkg, bf16* OUT, LAS char* lds) {
    const int tid = otid(), lane = tid & 63, wid = tid >> 6, r = lane & 31, h = lane >> 5;
    const size_t rb = (size_t)b * T;
    const bf16* xg = Z + rb * ZW + (s == 0 ? 1792 : 1856);
    const int n = 32 * nb + r, c = 32 * wid + r;
    const bf16* w1 = phi1t + (size_t)c * 2048;
    f32x16 acc;
#pragma unroll
    for (int i = 0; i < 16; ++i) acc[i] = 0.f;
#pragma unroll 8
    for (int ks = 0; ks < 128; ++ks) {
        const int p = ks >> 2, d0 = 16 * (ks & 3) + 8 * h;
        int tok = 16 * n + p; tok = tok > T - 1 ? T - 1 : tok;
        const u32x4 xa = *(const u32x4*)(xg + (size_t)tok * ZW + d0);
        const f32x4 p0 = *(const f32x4*)(pe + p * 64 + d0), p1 = *(const f32x4*)(pe + p * 64 + d0 + 4);
        const bf16x8 a = pack8(bflo(xa.x) + p0.x, bfhi(xa.x) + p0.y, bflo(xa.y) + p0.z, bfhi(xa.y) + p0.w, bflo(xa.z) + p1.x, bfhi(xa.z) + p1.y, bflo(xa.w) + p1.z, bfhi(xa.w) + p1.w);
        const bf16x8 bb = *(const bf16x8*)(w1 + 16 * ks + 8 * h);
        acc = MFMA32(a, bb, acc);
    }
    LAS bf16* hid = (LAS bf16*)lds; LAS float* ob = (LAS float*)(lds + 18432);
    const float bb1 = b1[c];
#pragma unroll
    for (int i = 0; i < 16; ++i) { const float v = gelu_tanh(acc[i] + bb1); hid[crow(i, h) * 264 + c] = (bf16)(pk2(v, 0.f) & 0xffffu); }
    __syncthreads();
    if (wid < 2) {
        const int e = 32 * wid + r;
        f32x16 a2;
#pragma unroll
        for (int i = 0; i < 16; ++i) a2[i] = 0.f;
        for (int ks = 0; ks < 16; ++ks) {
            const bf16x8 a = *(LAS const bf16x8*)((LAS const char*)hid + r * 528 + (16 * ks + 8 * h) * 2);
            float wv[8];
#pragma unroll
            for (int j = 0; j < 8; ++j) wv[j] = w2[(size_t)(16 * ks + 8 * h + j) * 64 + e];
            const bf16x8 bb = pack8(wv[0], wv[1], wv[2], wv[3], wv[4], wv[5], wv[6], wv[7]);
            a2 = MFMA32(a, bb, a2);
        }
        const float bb2 = b2[e];
#pragma unroll
        for (int i = 0; i < 16; ++i) ob[crow(i, h) * 65 + e] = a2[i] + bb2;
    }
    __syncthreads();
    {
        const int nl = tid >> 4, e4 = (tid & 15) * 4;
        float v[4];
#pragma unroll
        for (int j = 0; j < 4; ++j) v[j] = ob[nl * 65 + e4 + j];
        if (s == 0) {
            float ss = v[0] * v[0] + v[1] * v[1] + v[2] * v[2] + v[3] * v[3];
            ss += shx_(ss, 1); ss += shx_(ss, 2); ss += shx_(ss, 4); ss += shx_(ss, 8);
            const float rr = frsq(ss * (1.f / 64.f) + EPS);
#pragma unroll
            for (int j = 0; j < 4; ++j) v[j] *= rr * nkg[e4 + j];
        }
        const int nn = 32 * nb + nl;
        if (nn > 510) { v[0] = v[1] = v[2] = v[3] = 0.f; }
        u32x2 w; w.x = pk2(v[0], v[1]); w.y = pk2(v[2], v[3]);
        *(u32x2*)(OUT + ((size_t)b * 512 + nn) * 64 + e4) = w;
    }
    __syncthreads();
}

DI void merge_unit(int pm, int pn, const bf16* H, const bf16* BR, const bf16* Wg, const bf16* Wb, bf16* U, const float* SS, LAS char* lds) {
    const int tid = otid(), lane = tid & 63, wid = __builtin_amdgcn_readfirstlane(tid >> 6), r = lane & 31, h = lane >> 5, wr = wid >> 1, wc = wid & 1;
    const size_t row0 = (size_t)pm * 256; const int c0 = pn * 128;
    f32x16 A[2][2], Uacc[2][2];
    unsigned S[2][2][8];
#pragma unroll
    for (int a = 0; a < 2; ++a)
#pragma unroll
        for (int t = 0; t < 2; ++t)
#pragma unroll
            for (int i = 0; i < 16; ++i) { A[a][t][i] = 0.f; Uacc[a][t][i] = 0.f; }
    const float rs0 = row_scale_full(SS, row0 + 64 * wr + r), rs1 = row_scale_full(SS, row0 + 64 * wr + 32 + r);
    constexpr int AT = 256 * 128, BT = 128 * 128, BUFB = AT + BT, NS = 80;
    const int srow = lane >> 3, sch = lane & 7;
#define MG_DMA(s, slot) do { const int i_ = (s) / 20, j_ = (s) % 20; const bf16 *ap, *bp; int pb; \
        if (j_ < 16) { ap = H + row0 * 1024 + j_ * 64; bp = Wg + ((size_t)i_ * 1024 + c0) * 1024 + j_ * 64; pb = 1024; } \
        else { ap = BR + row0 * 1024 + 256 * i_ + (j_ - 16) * 64; bp = Wb + ((size_t)i_ * 1024 + c0) * 256 + (j_ - 16) * 64; pb = 256; } \
        LAS char* as_ = lds + (slot) * BUFB; LAS char* bs_ = as_ + AT; \
        _Pragma("unroll") for (int u_ = 0; u_ < 4; ++u_) { const int R_ = 8 * (wid * 4 + u_) + srow; const int ch_ = sch ^ ((R_ >> 1) & 7); \
            __builtin_amdgcn_global_load_lds((const unsigned*)(ap + (size_t)R_ * 1024 + ch_ * 8), (LAS unsigned*)(as_ + (wid * 4 + u_) * 1024), 16, 0, 0); } \
        _Pragma("unroll") for (int u_ = 0; u_ < 2; ++u_) { const int R_ = 8 * (wid * 2 + u_) + srow; const int ch_ = sch ^ ((R_ >> 1) & 7); \
            __builtin_amdgcn_global_load_lds((const unsigned*)(bp + (size_t)R_ * pb + ch_ * 8), (LAS unsigned*)(bs_ + (wid * 2 + u_) * 1024), 16, 0, 0); } } while (0)
#define MG_FRAG(base, R, c) (*(LAS const bf16x8*)((base) + (R) * 128 + (((c) ^ (((R) >> 1) & 7)) * 16)))
#define MG_STEP(MM) do { \
        if (s + 1 < NS) asm volatile("s_waitcnt vmcnt(6)" ::: "memory"); else asm volatile("s_waitcnt vmcnt(0)" ::: "memory"); \
        __builtin_amdgcn_s_barrier(); asm volatile("" ::: "memory"); \
        if (s + 2 < NS) MG_DMA(s + 2, sl2); \
        { LAS const char* as_ = lds + sl0 * BUFB; LAS const char* bs_ = as_ + AT; \
        __builtin_amdgcn_s_setprio(1); \
        _Pragma("unroll") for (int ks_ = 0; ks_ < 4; ++ks_) { const int c_ = 2 * ks_ + h; \
            const bf16x8 w0_ = MG_FRAG(bs_, 64 * wc + r, c_); const bf16x8 w1_ = MG_FRAG(bs_, 64 * wc + 32 + r, c_); \
            const bf16x8 h0_ = MG_FRAG(as_, 64 * wr + r, c_); const bf16x8 h1_ = MG_FRAG(as_, 64 * wr + 32 + r, c_); \
            A[0][0] = MM(w0_, h0_, A[0][0]); A[0][1] = MM(w0_, h1_, A[0][1]); A[1][0] = MM(w1_, h0_, A[1][0]); A[1][1] = MM(w1_, h1_, A[1][1]); } \
        __builtin_amdgcn_s_setprio(0); } \
        ++s; { const int t_ = sl0; sl0 = sl1; sl1 = sl2; sl2 = t_; } } while (0)
    asm volatile("s_waitcnt vmcnt(0)" ::: "memory");
    int s = 0, sl0 = 0, sl1 = 1, sl2 = 2; MG_DMA(0, 0); MG_DMA(1, 1);
    for (int i = 0; i < 4; ++i) {
        for (int j = 0; j < 16; ++j) MG_STEP(MFMA32H);
#pragma unroll
        for (int a = 0; a < 2; ++a)
#pragma unroll
            for (int t = 0; t < 2; ++t)
#pragma unroll
                for (int k = 0; k < 8; ++k) { const float rs = t ? rs1 : rs0; S[a][t][k] = pk2(sigmoidf_(A[a][t][2 * k] * rs), sigmoidf_(A[a][t][2 * k + 1] * rs)); A[a][t][2 * k] = 0.f; A[a][t][2 * k + 1] = 0.f; }
        for (int j = 0; j < 4; ++j) MG_STEP(MFMA32);
#pragma unroll
        for (int a = 0; a < 2; ++a)
#pragma unroll
            for (int t = 0; t < 2; ++t)
#pragma unroll
                for (int k = 0; k < 8; ++k) { Uacc[a][t][2 * k] += bflo(S[a][t][k]) * A[a][t][2 * k]; Uacc[a][t][2 * k + 1] += bfhi(S[a][t][k]) * A[a][t][2 * k + 1]; A[a][t][2 * k] = 0.f; A[a][t][2 * k + 1] = 0.f; }
    }
#undef MG_DMA
#undef MG_FRAG
#undef MG_STEP
#pragma unroll
    for (int a = 0; a < 2; ++a)
#pragma unroll
        for (int t = 0; t < 2; ++t) {
            bf16* dst = U + (row0 + 64 * wr + 32 * t + r) * 1024 + c0 + 64 * wc + 32 * a;
#pragma unroll
            for (int g = 0; g < 4; ++g) { u32x2 w; w.x = pk2(Uacc[a][t][4 * g], Uacc[a][t][4 * g + 1]); w.y = pk2(Uacc[a][t][4 * g + 2], Uacc[a][t][4 * g + 3]); *(u32x2*)(dst + 8 * g + 4 * h) = w; }
        }
    __syncthreads();
}

DI void conv_one(LAS unsigned char* lds, int l, int m, int g0, int ng, LAS float* scr) {
    unsigned char* wl = WSP + WS_W + (size_t)l * W_LAYER;
    const float* W; const float* gain = nullptr; bf16* WT; int map = 0, pitch, K, rows;
    if (m == 0) { W = IN(I_F1WI) + (size_t)l * D * 2 * FF; pitch = 2 * FF; K = D; rows = 2 * FF; WT = (bf16*)(wl + WO_W1IN); map = 1; gain = IN(I_F1N) + l * D; }
    else if (m == 1) { W = IN(I_F1WO) + (size_t)l * FF * D; pitch = D; K = FF; rows = D; WT = (bf16*)(wl + WO_W1OUT); }
    else if (m == 2) { W = IN(I_WIN) + (size_t)l * D * DIN; pitch = DIN; K = D; rows = ZW; WT = (bf16*)(wl + WO_WZ); map = 2; gain = IN(I_MIXN) + l * D; }
    else if (m == 3) { W = IN(I_WIN) + (size_t)l * D * DIN; pitch = DIN; K = D; rows = 4096; WT = (bf16*)(wl + WO_WG); map = 3; gain = IN(I_MIXN) + l * D; }
    else if (m < 8) { const int i = m - 4; W = IN(I_WBR) + ((size_t)l * 4 + i) * 256 * D; pitch = D; K = 256; rows = D; WT = (bf16*)(wl + WO_WB) + (size_t)i * D * 256; }
    else if (m == 8) { W = IN(I_WOUT) + (size_t)l * D * D; pitch = D; K = D; rows = D; WT = (bf16*)(wl + WO_WO); }
    else if (m == 9) { W = IN(I_F2WI) + (size_t)l * D * 2 * FF; pitch = 2 * FF; K = D; rows = 2 * FF; WT = (bf16*)(wl + WO_W2IN); map = 1; gain = IN(I_F2N) + l * D; }
    else if (m == 10) { W = IN(I_F2WO) + (size_t)l * FF * D; pitch = D; K = FF; rows = D; WT = (bf16*)(wl + WO_W2OUT); }
    else { const int s = m - 11; W = IN(I_PW1) + ((size_t)l * 2 + s) * 2048 * 256; pitch = 256; K = 2048; rows = 256; WT = (bf16*)(wl + WO_PHI1) + (size_t)s * 256 * 2048; }
    conv_matrix(map, W, pitch, K, rows, WT, scr, g0, ng, gain, m == 0 || m == 2 || m == 3 || m == 9);
}
DI void conv_set(LAS unsigned char* lds, int l, unsigned mask, int g0, int ng, LAS float* scr) {
    for (int m = 0; m < 13; ++m) if ((mask >> m) & 1u) conv_one(lds, l, m, g0, ng, scr);
}
#ifdef NO_DIFF
#define SK_DIFF(...)
#else
#define SK_DIFF(...) __VA_ARGS__
#endif
#ifdef NO_FOX
#define SK_FOX(...)
#else
#define SK_FOX(...) __VA_ARGS__
#endif
#ifdef NO_NSA
#define SK_NSA(...)
#else
#define SK_NSA(...) __VA_ARGS__
#endif
#ifdef NO_GMLP
#define SK_GMLP(...)
#else
#define SK_GMLP(...) __VA_ARGS__
#endif
#ifdef NO_MERGE
#define SK_MERGE(...)
#else
#define SK_MERGE(...) __VA_ARGS__
#endif
#ifdef NO_GZ
#define SK_GZ(...)
#else
#define SK_GZ(...) __VA_ARGS__
#endif
#ifdef NO_GS
#define SK_GS(...)
#else
#define SK_GS(...) __VA_ARGS__
#endif
#ifdef NO_GR
#define SK_GR(...)
#else
#define SK_GR(...) __VA_ARGS__
#endif
#ifdef NO_CMP
#define SK_CMP(...)
#else
#define SK_CMP(...) __VA_ARGS__
#endif
__global__ void __launch_bounds__(NTHR, 2) mega_fwd(Args args) {
    extern __shared__ __attribute__((aligned(16))) unsigned char lds_raw[];
    LAS unsigned char* lds = (LAS unsigned char*)lds_raw;
    cg::grid_group grid = cg::this_grid();
    const int tid = threadIdx.x, lane = tid & 63, wid = __builtin_amdgcn_readfirstlane(tid >> 6);
    if (lane == 0) *(LAS unsigned*)(uintptr_t)(WIDTAB_OFF + 4u * ((unsigned)__builtin_amdgcn_s_getreg((5 << 11) | 4) & 63u)) = (unsigned)wid;
    const int G = gridDim.x, bx = blockIdx.x;
    const int gw = bx * NWAVE + wid, ngw = G * NWAVE;
    if (tid < N_IN + 2) { const unsigned long long v = (tid < N_IN) ? (unsigned long long)args.in[tid < N_IN ? tid : 0] : (tid == N_IN ? (unsigned long long)args.out : (unsigned long long)args.ws);
        *(LAS unsigned long long*)(lds + PTAB_OFF + 8 * tid) = v; }
    if (tid < 2) ((LAS unsigned*)(lds + PTAB_OFF + 512))[tid] = 0u;
    __syncthreads();
    (void)xcd_barrier_post((unsigned*)(WSP + WS_CTL) + 4096, (volatile LAS unsigned*)(lds + PTAB_OFF + 512));
#define GSYNC() do { XcdBarrier b_; b_.bar = (unsigned*)(WSP + WS_CTL) + 4096; b_.x = xb_xcc_id(); b_.st = (volatile LAS unsigned*)(lds + PTAB_OFF + 512); xcd_barrier(b_); } while (0)
#define Hb ((bf16*)(WSP + WS_H))
#define BR ((bf16*)(WSP + WS_BR))
#define BIG ((bf16*)(WSP + WS_BIG))
#define MISC ((float*)(WSP + WS_MISC))
#define CUM ((float*)(WSP + WS_CUM))
#define KC ((bf16*)(WSP + WS_KC))
#define VC ((bf16*)(WSP + WS_VC))
#define SSB ((float*)(WSP + WS_SS))

    {
        LAS float* scr = (LAS float*)(lds + wid * 16384);
        conv_set(lds, 0, (1u << 0) | (1u << 3) | (1u << 9) | (1u << 10), gw, ngw, scr);
        for (int l = 1; l < DEPTH; ++l) conv_set(lds, l, (1u << 9) | (1u << 10), gw, ngw, scr);
        cast_rows(IN(I_X), Hb, SSB, (unsigned short*)OUTP, gw, ngw);
    }
    if (args.ws == nullptr) grid.sync();
    GSYNC();

    for (int l = 0; l < DEPTH; ++l) {
        unsigned char* wl = WSP + WS_W + (size_t)l * W_LAYER;
        { pg8::Gemm g{(const bf16*)OUTP, (const bf16*)(wl + WO_W1IN), M, 2 * FF, D}; pg8::StaticOrder S; S.init(M, 2 * FF, G, obx()); EpiSwiglu E{lds};
          SK_GS(pg8::gemm_phase<EpiSwiglu, pg8::StaticOrder, true, true, true>(lds, g, S, E)); }
        if (G == 256 && bx >= 128) conv_set(lds, l, (1u << 1) | (1u << 2), (bx - 128) * NWAVE + wid, 128 * NWAVE, (LAS float*)(lds + wid * 16384));
        else if (G != 256) conv_set(lds, l, (1u << 1) | (1u << 2), gw, ngw, (LAS float*)(lds + wid * 16384));
        GSYNC();
        { pg8::Gemm g{BIG, (const bf16*)(wl + WO_W1OUT), M, D, FF}; pg8::StaticOrder S; S.init(M, D, G, obx()); EpiResid E{lds, 1, 1, 0.5f};
          SK_GR(pg8::gemm_phase<EpiResid, pg8::StaticOrder, true, true>(lds, g, S, E)); }
        GSYNC();
        { pg8::Gemm g{(const bf16*)OUTP, (const bf16*)(wl + WO_WZ), M, ZW, D}; pg8::StaticOrder S; S.init(M, ZW, G, obx());
          EpiZ E{lds, l};
          SK_GZ(pg8::gemm_phase<EpiZ, pg8::StaticOrder, true, true, true>(lds, g, S, E)); }
        if (G == 256 && bx >= 192) conv_set(lds, l, 0xf0u | (1u << 8) | (3u << 11), (bx - 192) * NWAVE + wid, 64 * NWAVE, (LAS float*)(lds + wid * 16384));
        else if (G != 256) conv_set(lds, l, 0xf0u | (1u << 8) | (3u << 11), gw, ngw, (LAS float*)(lds + wid * 16384));
        GSYNC();
        {
            float lam, lam_init;
            { const float* lp = IN(I_DLAM) + l * 128; float s01 = 0.f, s23 = 0.f; for (int i = 0; i < 32; ++i) { s01 += lp[i] * lp[32 + i]; s23 += lp[64 + i] * lp[96 + i]; }
              lam_init = 0.8f - 0.6f * __expf(-0.3f * (float)l); lam = __expf(s01) - __expf(s23) + lam_init; }
            unsigned* ctr = (unsigned*)(WSP + WS_CTL) + 64 * (1 + l);
            unsigned* dcum = (unsigned*)(WSP + WS_CTL) + 64 * (4 + 2 * l);
            unsigned* dcmp = (unsigned*)(WSP + WS_CTL) + 64 * (5 + 2 * l);
            LAS int* slot = (LAS int*)(lds + L_Q);
#define DEP_WAIT(p_, n_) do { if (otid() == 0) { while (__hip_atomic_load((p_), __ATOMIC_RELAXED, __HIP_MEMORY_SCOPE_AGENT) < (unsigned)(n_)) __builtin_amdgcn_s_sleep(2); \
        __builtin_amdgcn_fence(__ATOMIC_ACQUIRE, "agent"); asm volatile("s_waitcnt vmcnt(0)" ::: "memory"); } __syncthreads(); } while (0)
            for (;;) {
                __syncthreads();
                if (otid() == 0) *slot = (int)atomicAdd(ctr, 1u);
                __syncthreads();
                const int u0 = *slot;
                if (u0 >= 72 + 768 + 512) break;
                if (u0 < 72) {
                    if (u0 < 8) cumsum_unit(u0 >> 2, u0 & 3, MISC, CUM, (LAS char*)lds);
                    else { SK_CMP( const int v = u0 - 8; const int s = v >> 5; const int b = (v >> 4) & 1; const int nb = v & 15;
                        compress_unit(l, s, b, nb, BIG, (const bf16*)(wl + WO_PHI1) + (size_t)s * 256 * 2048, IN(I_PE) + ((size_t)l * 2 + s) * 2048, IN(I_PB1) + (l * 2 + s) * 256,
                                      IN(I_PW2) + ((size_t)l * 2 + s) * 256 * 64, IN(I_PB2) + (l * 2 + s) * 64, IN(I_NKG) + l * 64, s == 0 ? KC : VC, (LAS char*)lds); ) }
                    asm volatile("s_waitcnt vmcnt(0)" ::: "memory"); __syncthreads();
                    if (otid() == 0) { __builtin_amdgcn_fence(__ATOMIC_RELEASE, "agent"); asm volatile("s_waitcnt vmcnt(0)" ::: "memory");
                        __hip_atomic_fetch_add(u0 < 8 ? dcum : dcmp, 1u, __ATOMIC_RELAXED, __HIP_MEMORY_SCOPE_AGENT); }
                    continue;
                }
                const int v = u0 - 72;
                int kind, lvl, k;
                if (v < 160) { kind = 0; lvl = 31 - (v >> 3); k = v & 7; }
                else if (v >= 512 && v < 768) { const int w = v - 512; kind = 1; lvl = 31 - (w >> 3); k = w & 7; }
                else if (v < 512) { int w = v - 160; kind = 2; lvl = 0; k = 0;
                    for (int i = 0; i < 32; ++i) {
                        if (w < 8) { kind = 2; lvl = 31 - i; k = w; break; } w -= 8;
                        const int dl = (i == 31) ? 0 : ((i % 3 == 0) ? 11 - i / 3 : -1);
                        if (dl >= 0) { if (w < 8) { kind = 0; lvl = dl; k = w; break; } w -= 8; }
                    } }
                else { kind = 3; lvl = 0; k = v - 768; }
                if (kind == 0) {
                    const float bnd = 32.f * 0.17677669529663687f * LOG2E * 1.01f * gain_max(IN(I_DQG) + l * 32, 32) * gain_max(IN(I_DKG) + l * 32, 32);
                    if (bnd > 60.f) { SK_DIFF(attn_unit<true, true>(k >> 2, k & 3, lvl, BIG, CUM, BR, lam, lam_init, nullptr, (LAS char*)lds)); }
                    else { SK_DIFF(attn_unit<true, false>(k >> 2, k & 3, lvl, BIG, CUM, BR, lam, lam_init, nullptr, (LAS char*)lds)); } }
                else if (kind == 1) { DEP_WAIT(dcum, 8); SK_FOX(attn_unit<false>(k >> 2, k & 3, lvl, BIG, CUM, BR, lam, lam_init, IN(I_FKG) + l * 64, (LAS char*)lds)); }
                else if (kind == 2) { DEP_WAIT(dcmp, 64); SK_NSA(nsa_unit(k & 1, 4 * lvl + 3 - (k >> 1), BIG, KC, VC, MISC, BR, (LAS char*)lds)); }
                else { SK_GMLP(gmlp_unit(k >> 8, (k >> 2) & 63, k & 3, l, BIG, IN(I_GWS), IN(I_GBS), BR, (LAS char*)lds)); }
            }
#undef DEP_WAIT
        }
        GSYNC();
        for (int u = ((G % 8 == 0) ? (bx % 8) * (G / 8) + bx / 8 : bx); u < 64 * 8; u += G) { SK_MERGE(merge_unit(u >> 3, u & 7,     (const bf16*)OUTP, BR, (const bf16*)(wl + WO_WG), (const bf16*)(wl + WO_WB), BIG, SSB, (LAS char*)lds)); }
        GSYNC();
        { pg8::Gemm g{BIG, (const bf16*)(wl + WO_WO), M, D, D}; pg8::StaticOrder S; S.init(M, D, G, obx()); EpiResid E{lds, 1, (l + 1 == DEPTH) ? 2 : 1, 1.0f};
          SK_GR(pg8::gemm_phase<EpiResid, pg8::StaticOrder, true, true>(lds, g, S, E)); }
        GSYNC();
        { pg8::Gemm g{(l + 1 == DEPTH) ? (const bf16*)BR : (const bf16*)OUTP, (const bf16*)(wl + WO_W2IN), M, 2 * FF, D}; pg8::StaticOrder S; S.init(M, 2 * FF, G, obx()); EpiSwiglu E{lds};
          SK_GS(pg8::gemm_phase<EpiSwiglu, pg8::StaticOrder, true, true, true>(lds, g, S, E)); }
        if (l + 1 < DEPTH) { if (G == 256 && bx >= 128) conv_set(lds, l + 1, (1u << 0) | (1u << 3), (bx - 128) * NWAVE + wid, 128 * NWAVE, (LAS float*)(lds + wid * 16384));
            else if (G != 256) conv_set(lds, l + 1, (1u << 0) | (1u << 3), gw, ngw, (LAS float*)(lds + wid * 16384)); }
        GSYNC();
        { pg8::Gemm g{BIG, (const bf16*)(wl + WO_W2OUT), M, D, FF}; pg8::StaticOrder S; S.init(M, D, G, obx()); EpiResid E{lds, (l + 1 == DEPTH) ? 2 : 1, (l + 1 == DEPTH) ? 3 : 1, 0.5f};
          SK_GR(pg8::gemm_phase<EpiResid, pg8::StaticOrder, true, true>(lds, g, S, E)); }
        if (l + 1 < DEPTH) { GSYNC(); }
    }
}

extern "C" void kernel_launch(void* const* d_in, const int* in_sizes, int n_in, void* d_out, int out_size, void* d_ws, size_t ws_size, hipStream_t stream) {
    static int grid = 0;
    if (grid == 0) {
        if (n_in != N_IN || out_size != M * D || ws_size < WS_END) { fprintf(stderr, "kernel_launch: unexpected shapes n_in %d out %d ws %zu (need %zu)\n", n_in, out_size, ws_size, (size_t)WS_END); grid = -1; return; }
        int dev = 0, cus = 0, per_cu = 0;
        hipGetDevice(&dev); hipDeviceGetAttribute(&cus, hipDeviceAttributeMultiprocessorCount, dev);
        hipFuncSetAttribute((const void*)mega_fwd, hipFuncAttributeMaxDynamicSharedMemorySize, LDS_BYTES);
        hipOccupancyMaxActiveBlocksPerMultiprocessor(&per_cu, (const void*)mega_fwd, NTHR, LDS_BYTES);
        if (per_cu < 1) { fprintf(stderr, "kernel_launch: occupancy query says %d blocks/CU\n", per_cu); per_cu = 1; }
        if (per_cu > 1) per_cu = 1;
        grid = cus * per_cu;
    }
    if (grid < 0) return;
    hipMemsetAsync((char*)d_ws + WS_CTL, 0, 65536, stream);
    Args a{};
    for (int i = 0; i < N_IN; ++i) a.in[i] = (const float*)d_in[i];
    a.out = (float*)d_out; a.ws = (unsigned char*)d_ws;
    void* kargs[] = {&a};
    hipError_t e = hipLaunchCooperativeKernel((const void*)mega_fwd, dim3(grid), dim3(NTHR), kargs, LDS_BYTES, stream);
    if (e != hipSuccess) fprintf(stderr, "cooperative launch failed: %s (grid %d)\n", hipGetErrorString(e), grid);
}
```

```cpp
#include <hip/hip_runtime.h>
#include <hip/hip_cooperative_groups.h>
#include <cstdio>
#include <cstdint>
namespace cg = cooperative_groups;
constexpr int WIDTAB_OFF = 147456 + 2048;
__device__ __forceinline__ int otid() {
    unsigned z = 0u; asm volatile("" : "+v"(z));
    const unsigned hw = (unsigned)__builtin_amdgcn_s_getreg((5 << 11) | 4) & 63u;
    const unsigned w = *(const __attribute__((address_space(3))) unsigned*)(uintptr_t)(WIDTAB_OFF + 4u * hw + z);
    return (int)(__builtin_amdgcn_readfirstlane(w) * 64u + __builtin_amdgcn_mbcnt_hi(~0u, __builtin_amdgcn_mbcnt_lo(~0u, z)));
}
namespace pg8 {
#define PG8_LAS __attribute__((address_space(3)))
typedef unsigned short bf16_t;
typedef short bf16x8 __attribute__((ext_vector_type(8)));
typedef float f32x4 __attribute__((ext_vector_type(4)));
typedef unsigned u32x4 __attribute__((ext_vector_type(4)));
constexpr int BM = 256, BK = 64, HALF = 128, HTB = HALF * BK * 2  , STAGE_BYTES = 8 * HTB, NXCD = 8, WGM = 8;

__host__ __device__ __forceinline__ int lds_byte(int r, int c) { const int st = (r >> 4) * 2 + (c >> 5), rr = r & 15, cc = c & 31, ob = rr * 64 + cc * 2; return st * 1024 + (ob ^ (((ob >> 9) & 1) << 5)); }
__host__ __device__ __forceinline__ void stage_rc(int b, int& R, int& C) { const int st = b / 1024, sb = b % 1024, swz = sb ^ (((sb >> 9) & 1) << 5); R = (st >> 1) * 16 + swz / 64; C = (st & 1) * 32 + (swz % 64) / 2; }
__host__ __device__ __forceinline__ int perm32(int rho) { const int n = rho >> 4, i = rho & 15; return 8 * (i >> 2) + 4 * n + (i & 3); }

struct Unit { int pm, pn; };
struct Gemm { const bf16_t* A; const bf16_t* Bt; int M, N, K; };

struct StaticOrder {
    int nM, nN, nwg, G, c;
    __host__ __device__ void init(int M, int N, int G_, int c_) { nM = M / BM; nN = N / BM; nwg = nM * nN; G = G_; c = c_; }
    __host__ __device__ bool next(int i, Unit& u) const {
        const long L = (long)i * G + c; if (L >= nwg) return false;
        int wgid = (int)L; { const int q = nwg / NXCD, r = nwg % NXCD, xcd = wgid % NXCD, off = wgid / NXCD; wgid = (xcd < r ? xcd * (q + 1) : r * (q + 1) + (xcd - r) * q) + off; }
        const int nig = WGM * nN, gid = wgid / nig, fm = gid * WGM, gsz = (nM - fm) < WGM ? (nM - fm) : WGM;
        u.pm = fm + ((wgid % nig) % gsz); u.pn = (wgid % nig) / gsz; return true;
    }
    __device__ __forceinline__ void a_ready(const Unit&) const {}
    __device__ __forceinline__ void done(const Unit&) const {}
};

__device__ __forceinline__ unsigned cvt_pk_bf16(float lo, float hi) { unsigned r; asm volatile("v_cvt_pk_bf16_f32 %0, %1, %2" : "=v"(r) : "v"(lo), "v"(hi)); return r; }
typedef _Float16 f16x8 __attribute__((ext_vector_type(8)));
template <bool F16> __device__ __forceinline__ f32x4 mma16(bf16x8 b, bf16x8 a, f32x4 c) {
    if constexpr (F16) return __builtin_amdgcn_mfma_f32_16x16x32_f16(__builtin_bit_cast(f16x8, b), __builtin_bit_cast(f16x8, a), c, 0, 0, 0);
    else return __builtin_amdgcn_mfma_f32_16x16x32_bf16(b, a, c, 0, 0, 0);
}
template <class Epi, class Sched, bool ALIGN_EPI = false, bool SP2 = false, bool F16 = false>
__device__ __forceinline__ void gemm_phase(PG8_LAS unsigned char* lds, const Gemm g, const Sched& S, const Epi& E) {
    int tid_ = ::otid();
    const int tid = tid_, wid = __builtin_amdgcn_readfirstlane(tid >> 6), lane = tid & 63, wr = wid >> 2, wc = wid & 3, fr = lane & 15, fq = lane >> 4;
    const int K = g.K, nt = K / BK;
    unsigned voffA[2], voffB[2];
#pragma unroll
    for (int i = 0; i < 2; ++i) { int R, C; stage_rc(tid * 16 + i * 8192, R, C); const int Rb = Epi::PERM ? ((R & ~31) + perm32(R & 31)) : R;
        voffA[i] = (unsigned)(R * K + C) * 2u; voffB[i] = (unsigned)(Rb * K + C) * 2u; }
    const size_t kstep = (size_t)(BK * 2);
    const size_t hstep = (size_t)HALF * K * 2;
    const size_t tstep = 2 * hstep;
    const unsigned ldsw = (unsigned)wid * 1024u;
    const int aoff = lds_byte(wr * 64 + fr, fq * 8), boff = lds_byte(wc * 32 + fr, fq * 8);
#define PG8_SA(b, h) (((b) * 2 + (h)) * HTB)
#define PG8_SB(b, h) ((4 + (b) * 2 + (h)) * HTB)
#define PG8_STAGE(bufoff, gbase, voff) do { _Pragma("unroll") for (int _i = 0; _i < 2; ++_i) \
        __builtin_amdgcn_global_load_lds((const unsigned*)((const char*)(gbase) + (voff)[_i]), (PG8_LAS unsigned*)(lds + (bufoff) + ldsw + _i * 8192), 16, 0, 0); } while (0)
#define PG8_LDA(dst, b, h) do { _Pragma("unroll") for (int m = 0; m < 4; ++m) _Pragma("unroll") for (int k = 0; k < 2; ++k) dst[m][k] = *(const PG8_LAS bf16x8*)(lds + PG8_SA(b, h) + aoff + m * 2048 + k * 1024); } while (0)
#define PG8_LDB(dst, b, h) do { _Pragma("unroll") for (int n = 0; n < 2; ++n) _Pragma("unroll") for (int k = 0; k < 2; ++k) dst[n][k] = *(const PG8_LAS bf16x8*)(lds + PG8_SB(b, h) + boff + n * 2048 + k * 1024); } while (0)
#define PG8_MMA(ai, bj, At, Bt) do { __builtin_amdgcn_s_setprio(1); _Pragma("unroll") for (int m = 0; m < 4; ++m) _Pragma("unroll") for (int n = 0; n < 2; ++n) _Pragma("unroll") for (int k = 0; k < 2; ++k) \
        acc[ai][bj][m][n] = mma16<F16>(Bt[n][k], At[m][k], acc[ai][bj][m][n]); __builtin_amdgcn_s_setprio(0); } while (0)
#define PG8_WAIT_V(n) asm volatile("s_waitcnt vmcnt(" #n ")" ::: "memory")
#define PG8_WAIT_L(n) asm volatile("s_waitcnt lgkmcnt(" #n ")" ::: "memory")
#define PG8_BAR __builtin_amdgcn_s_barrier()
#define PG8_SCHED __builtin_amdgcn_sched_barrier(0)
    Unit cur, nxt; int ui = 0;
    if (!S.next(0, cur)) return;
    f32x4 acc[2][2][4][2];
#pragma unroll
    for (int a = 0; a < 2; ++a)
#pragma unroll
        for (int b = 0; b < 2; ++b)
#pragma unroll
            for (int m = 0; m < 4; ++m)
#pragma unroll
                for (int n = 0; n < 2; ++n) acc[a][b][m][n] = (f32x4){0.f, 0.f, 0.f, 0.f};
    bf16x8 At[4][2], B0[2][2], B1[2][2];
    const char* cA = (const char*)g.A + (size_t)cur.pm * tstep; const char* cB = (const char*)g.Bt + (size_t)cur.pn * tstep;
    S.a_ready(cur);
    if constexpr (SP2) {
        PG8_STAGE(PG8_SB(0, 0), cB, voffB); PG8_STAGE(PG8_SB(0, 1), cB + hstep, voffB); PG8_STAGE(PG8_SA(0, 0), cA, voffA); PG8_STAGE(PG8_SA(0, 1), cA + hstep, voffA);
        if (wr == 1) PG8_BAR;
        PG8_WAIT_V(2); PG8_BAR;
        PG8_STAGE(PG8_SB(1, 0), cB + kstep, voffB); PG8_STAGE(PG8_SA(1, 0), cA + kstep, voffA); PG8_STAGE(PG8_SB(1, 1), cB + hstep + kstep, voffB);
        PG8_WAIT_V(6); PG8_BAR;
    } else {
        PG8_STAGE(PG8_SB(0, 0), cB, voffB); PG8_STAGE(PG8_SA(0, 0), cA, voffA); PG8_STAGE(PG8_SB(0, 1), cB + hstep, voffB); PG8_STAGE(PG8_SA(0, 1), cA + hstep, voffA);
        if (wr == 1) PG8_BAR;
        PG8_WAIT_V(4); PG8_BAR;
        PG8_STAGE(PG8_SB(1, 0), cB + kstep, voffB); PG8_STAGE(PG8_SA(1, 0), cA + kstep, voffA); PG8_STAGE(PG8_SB(1, 1), cB + hstep + kstep, voffB);
        PG8_WAIT_V(6); PG8_BAR;
    }
    for (;;) {
        const bool has_next = S.next(ui + 1, nxt);
        const char* nA = has_next ? (const char*)g.A + (size_t)nxt.pm * tstep : cA; const char* nB = has_next ? (const char*)g.Bt + (size_t)nxt.pn * tstep : cB;
        for (int t = 0; t < nt; t += 2) {
            const bool last = (t == nt - 2);
            const char* a1 = cA + (size_t)(t + 1) * kstep;
            const char* a2 = last ? nA : cA + (size_t)(t + 2) * kstep; const char* b2 = last ? nB : cB + (size_t)(t + 2) * kstep;
            const char* a3 = a2 + kstep; const char* b3 = b2 + kstep;
            if (last && has_next) S.a_ready(nxt);
            if constexpr (SP2) {
            PG8_LDB(B0, 0, 0); PG8_LDB(B1, 0, 1); PG8_SCHED; PG8_LDA(At, 0, 0); PG8_STAGE(PG8_SA(1, 1), a1 + hstep, voffA);
            PG8_WAIT_V(8); PG8_WAIT_L(0); PG8_BAR; PG8_MMA(0, 0, At, B0); PG8_MMA(0, 1, At, B1); PG8_BAR; PG8_SCHED;
            PG8_LDA(At, 0, 1); PG8_STAGE(PG8_SB(0, 0), b2, voffB); PG8_STAGE(PG8_SB(0, 1), b2 + hstep, voffB); PG8_STAGE(PG8_SA(0, 0), a2, voffA);
            PG8_WAIT_V(8); PG8_WAIT_L(0); PG8_BAR; PG8_MMA(1, 0, At, B0); PG8_MMA(1, 1, At, B1); PG8_BAR; PG8_SCHED;
            PG8_LDB(B0, 1, 0); PG8_LDB(B1, 1, 1); PG8_SCHED; PG8_LDA(At, 1, 0); PG8_STAGE(PG8_SA(0, 1), a2 + hstep, voffA);
            PG8_WAIT_V(8); PG8_WAIT_L(0); PG8_BAR; PG8_MMA(0, 0, At, B0); PG8_MMA(0, 1, At, B1); PG8_BAR; PG8_SCHED;
            PG8_LDA(At, 1, 1); PG8_STAGE(PG8_SB(1, 0), b3, voffB); PG8_STAGE(PG8_SB(1, 1), b3 + hstep, voffB); PG8_STAGE(PG8_SA(1, 0), a3, voffA);
            PG8_WAIT_V(8); PG8_WAIT_L(0); PG8_BAR; PG8_MMA(1, 0, At, B0); PG8_MMA(1, 1, At, B1); PG8_BAR; PG8_SCHED;
            } else {
            PG8_LDB(B0, 0, 0); PG8_SCHED; PG8_LDA(At, 0, 0); PG8_STAGE(PG8_SA(1, 1), a1 + hstep, voffA);
            PG8_WAIT_L(8); PG8_BAR; PG8_WAIT_L(0); PG8_MMA(0, 0, At, B0); PG8_BAR; PG8_SCHED;
            PG8_LDB(B1, 0, 1); PG8_STAGE(PG8_SB(0, 0), b2, voffB);
            PG8_BAR; PG8_WAIT_L(0); PG8_MMA(0, 1, At, B1); PG8_BAR;
            PG8_LDA(At, 0, 1); PG8_STAGE(PG8_SA(0, 0), a2, voffA);
            PG8_BAR; PG8_WAIT_L(0); PG8_MMA(1, 0, At, B0); PG8_BAR; PG8_SCHED;
            PG8_STAGE(PG8_SB(0, 1), b2 + hstep, voffB);
            PG8_WAIT_V(6); PG8_BAR; PG8_MMA(1, 1, At, B1); PG8_BAR;
            PG8_LDB(B0, 1, 0); PG8_SCHED; PG8_LDA(At, 1, 0); PG8_STAGE(PG8_SA(0, 1), a2 + hstep, voffA);
            PG8_WAIT_L(8); PG8_BAR; PG8_WAIT_L(0); PG8_MMA(0, 0, At, B0); PG8_BAR; PG8_SCHED;
            PG8_LDB(B1, 1, 1); PG8_STAGE(PG8_SB(1, 0), b3, voffB);
            PG8_BAR; PG8_WAIT_L(0); PG8_MMA(0, 1, At, B1); PG8_BAR;
            PG8_LDA(At, 1, 1); PG8_STAGE(PG8_SA(1, 0), a3, voffA);
            PG8_BAR; PG8_WAIT_L(0); PG8_MMA(1, 0, At, B0); PG8_BAR; PG8_SCHED;
            PG8_STAGE(PG8_SB(1, 1), b3 + hstep, voffB);
            PG8_WAIT_V(6); PG8_BAR; PG8_MMA(1, 1, At, B1); PG8_BAR;
            }
        }
        if constexpr (ALIGN_EPI) { if (wr == 0) PG8_BAR; }
        if constexpr (!Epi::AFTER_DRAIN) { E(acc, cur, wr, wc, fr, fq); S.done(cur); }
        if (!has_next) break;
#pragma unroll
        for (int a = 0; a < 2; ++a)
#pragma unroll
            for (int b = 0; b < 2; ++b)
#pragma unroll
                for (int m = 0; m < 4; ++m)
#pragma unroll
                    for (int n = 0; n < 2; ++n) acc[a][b][m][n] = (f32x4){0.f, 0.f, 0.f, 0.f};
        cur = nxt; cA = nA; cB = nB; ++ui;
        if constexpr (ALIGN_EPI) { if (wr == 1) PG8_BAR; }
    }
    PG8_WAIT_V(0);
    if constexpr (!ALIGN_EPI) { if (wr == 0) PG8_BAR; }
    PG8_BAR;
    if constexpr (Epi::AFTER_DRAIN) { E.fused(acc, cur, wr, wc, fr, fq, lds, wid, lane); S.done(cur); }
#undef PG8_SA
#undef PG8_SB
#undef PG8_STAGE
#undef PG8_LDA
#undef PG8_LDB
#undef PG8_MMA
#undef PG8_WAIT_V
#undef PG8_WAIT_L
#undef PG8_BAR
#undef PG8_SCHED
}
}

#define LAS __attribute__((address_space(3)))
#define DI __device__ __forceinline__
typedef unsigned short bf16;
typedef short bf16x8 __attribute__((ext_vector_type(8)));
typedef short s16x4 __attribute__((ext_vector_type(4)));
typedef float f32x2 __attribute__((ext_vector_type(2)));
typedef float f32x4 __attribute__((ext_vector_type(4)));
typedef float f32x16 __attribute__((ext_vector_type(16)));
typedef unsigned u32x4 __attribute__((ext_vector_type(4)));
typedef unsigned u32x2 __attribute__((ext_vector_type(2)));
typedef __bf16 bf16x2_t __attribute__((ext_vector_type(2)));
#define MFMA32(a, b, c) __builtin_amdgcn_mfma_f32_32x32x16_bf16((a), (b), (c), 0, 0, 0)
typedef _Float16 f16x8_t __attribute__((ext_vector_type(8)));
#define MFMA32H(a, b, c) __builtin_amdgcn_mfma_f32_32x32x16_f16(__builtin_bit_cast(f16x8_t, (a)), __builtin_bit_cast(f16x8_t, (b)), (c), 0, 0, 0)

constexpr int T = 8192, NBATCH = 2, M = NBATCH * T, D = 1024, FF = 2816, ZW = 2816, DIN = 6800, DEPTH = 2;
constexpr float LOG2E = 1.4426950408889634f, EPS = 1e-6f;
constexpr int NTHR = 512, NWAVE = 8;
constexpr int LDS_BYTES = 163840;

DI unsigned pk2(float lo, float hi) { f32x2 v = {lo, hi}; bf16x2_t b = __builtin_convertvector(v, bf16x2_t); return __builtin_bit_cast(unsigned, b); }
DI float bf2f(unsigned short v) { return __uint_as_float((unsigned)v << 16); }
DI float bflo(unsigned w) { return __uint_as_float(w << 16); }
DI float bfhi(unsigned w) { return __uint_as_float(w & 0xffff0000u); }
DI float fexp2(float x) { return __builtin_amdgcn_exp2f(x); }
DI float frcp(float x) { return __builtin_amdgcn_rcpf(x); }
DI float frsq(float x) { return __builtin_amdgcn_rsqf(x); }
DI float sigmoidf_(float x) { return frcp(1.f + fexp2(-x * LOG2E)); }
DI float gelu_tanh(float x) { const float y = 0.7978845608028654f * (x + 0.044715f * x * x * x); return x * frcp(1.f + fexp2(-2.f * LOG2E * y)); }
DI float log_sigmoid(float x) { return fminf(x, 0.f) - log1pf(__expf(-fabsf(x))); }
DI int obx() { int b = blockIdx.x; asm volatile("" : "+s"(b)); return b; }
DI int lane_id_local() { unsigned z = 0u; asm volatile("" : "+v"(z)); return (int)__builtin_amdgcn_mbcnt_hi(~0u, __builtin_amdgcn_mbcnt_lo(~0u, z)); }
DI int shx_(int v, int m) { return __builtin_amdgcn_ds_bpermute((lane_id_local() ^ m) << 2, v); }
DI float shx_(float v, int m) { return __int_as_float(__builtin_amdgcn_ds_bpermute((lane_id_local() ^ m) << 2, __float_as_int(v))); }
DI unsigned shx_(unsigned v, int m) { return (unsigned)__builtin_amdgcn_ds_bpermute((lane_id_local() ^ m) << 2, (int)v); }
DI float shup_(float v, int o) { const int l = lane_id_local(); return __int_as_float(__builtin_amdgcn_ds_bpermute((l >= o ? l - o : l) << 2, __float_as_int(v))); }
DI float h2f_(unsigned h) { const _Float16 v = __builtin_bit_cast(_Float16, (unsigned short)h); return (float)v; }
DI unsigned f2h_(float f) { const _Float16 v = (_Float16)f; return (unsigned)__builtin_bit_cast(unsigned short, v); }
DI unsigned pkh2(float a, float b) { return f2h_(a) | (f2h_(b) << 16); }
DI f32x4 unpkh4(u32x2 w) { return (f32x4){h2f_(w.x & 0xffffu), h2f_(w.x >> 16), h2f_(w.y & 0xffffu), h2f_(w.y >> 16)}; }
DI int crow(int i, int h) { return (i & 3) + 8 * (i >> 2) + 4 * h; }
DI bf16x8 pack8(float a0, float a1, float a2, float a3, float a4, float a5, float a6, float a7) {
    u32x4 p; p.x = pk2(a0, a1); p.y = pk2(a2, a3); p.z = pk2(a4, a5); p.w = pk2(a6, a7); return __builtin_bit_cast(bf16x8, p); }
DI s16x4 tr_read(LAS const char* p) { return __builtin_bit_cast(s16x4, __builtin_amdgcn_ds_read_tr16_b64_v4i16((LAS s16x4*)p)); }
DI bf16x8 cat8(s16x4 lo, s16x4 hi) { return __builtin_shufflevector(lo, hi, 0, 1, 2, 3, 4, 5, 6, 7); }

#define XB_TMO      128
#define XB_XCNT(j)  (256  + 64 * (j))
#define XB_XSUB(j)  (1280 + 64 * (j))
#define XB_XGEN(j)  (2304 + 64 * (j))
#define XB_TOP      3328
#define XB_TOPGEN   3392
#define XCD_BAR_WORDS 3456
#define XB_SPIN_CAP (1u << 18)

__device__ __forceinline__ unsigned xb_ld(unsigned* p)              { return __hip_atomic_load(p, __ATOMIC_RELAXED, __HIP_MEMORY_SCOPE_AGENT); }
__device__ __forceinline__ unsigned xb_add(unsigned* p, unsigned v) { return __hip_atomic_fetch_add(p, v, __ATOMIC_RELAXED, __HIP_MEMORY_SCOPE_AGENT); }
__device__ __forceinline__ unsigned xb_xcc_id() { return (unsigned)__builtin_amdgcn_s_getreg((3 << 11) | 20) & 0xFu; }
#define XB_SPIN(cond, bar) do { unsigned _sp = 0; while (cond) { __builtin_amdgcn_s_sleep(1); \
    if ((++_sp & 255u) == 0u) { if (xb_ld(&(bar)[XB_TMO])) break; if (_sp > XB_SPIN_CAP) { atomicAdd(&(bar)[XB_TMO], 1u); break; } } } } while (0)

struct XcdBarrier {
    unsigned* bar; unsigned x;
    volatile LAS unsigned* st;
};

__device__ __forceinline__ XcdBarrier xcd_barrier_post(unsigned* bar, volatile LAS unsigned* st) {
    XcdBarrier b; b.bar = bar; b.x = xb_xcc_id(); b.st = st;
    if (threadIdx.x == 0) (void)xb_add(&bar[XB_XCNT(b.x)], 1u);
    return b;
}
__device__ __forceinline__ void xcd_barrier_complete(unsigned* bar, unsigned x, unsigned& nloc, unsigned& nx) {
    const unsigned G = gridDim.x * gridDim.y * gridDim.z;
    unsigned sum, cnt, mine, sp = 0u;
    for (;;) {
        sum = 0u; cnt = 0u; mine = 0u;
#pragma unroll
        for (unsigned j = 0; j < 16; ++j) { const unsigned c = xb_ld(&bar[XB_XCNT(j)]); sum += c; cnt += (c > 0u) ? 1u : 0u; mine = (j == x) ? c : mine; }
        if (sum == G) break;
        __builtin_amdgcn_s_sleep(1);
        if ((++sp & 255u) == 0u) { if (xb_ld(&bar[XB_TMO])) break; if (sp > XB_SPIN_CAP) { atomicAdd(&bar[XB_TMO], 1u); break; } }
    }
    nloc = mine > 0u ? mine : 1u; nx = cnt > 0u ? cnt : 1u;
}

__device__ __forceinline__ void xcd_barrier(const XcdBarrier& b) {
    asm volatile("s_waitcnt vmcnt(0)" ::: "memory");
    __syncthreads();
    if (otid() == 0) {
        unsigned* bar = b.bar;
        __builtin_amdgcn_s_waitcnt(0);
        unsigned nloc = b.st[0], nx = b.st[1];
        if (nloc == 0u) { xcd_barrier_complete(bar, b.x, nloc, nx); b.st[0] = nloc; b.st[1] = nx; }
        const unsigned old = xb_add(&bar[XB_XSUB(b.x)], 1u);
        const unsigned gen = old / nloc;
        if (old + 1u == (gen + 1u) * nloc) {
            __builtin_amdgcn_fence(__ATOMIC_RELEASE, "agent");
            asm volatile("s_waitcnt vmcnt(0)" ::: "memory");
            const unsigned og = xb_add(&bar[XB_TOP], 1u);
            const unsigned tg = og / nx;
            if (og + 1u == (tg + 1u) * nx) xb_add(&bar[XB_TOPGEN], 1u);
            else XB_SPIN(xb_ld(&bar[XB_TOPGEN]) == tg, bar);
            __builtin_amdgcn_fence(__ATOMIC_ACQUIRE, "agent");
            xb_add(&bar[XB_XGEN(b.x)], 1u);
            asm volatile("s_waitcnt vmcnt(0)" ::: "memory");
        } else {
            XB_SPIN(xb_ld(&bar[XB_XGEN(b.x)]) == gen, bar);
            __builtin_amdgcn_fence(__ATOMIC_ACQUIRE, "agent");
            asm volatile("s_waitcnt vmcnt(0)" ::: "memory");
        }
    }
    __syncthreads();
}

constexpr size_t MiB = 1u << 20;
constexpr size_t WS_CTL = 0;
constexpr size_t WSZ_W1IN = (size_t)5632 * 1024 * 2, WSZ_W1OUT = (size_t)1024 * 2816 * 2, WSZ_WZ = (size_t)2816 * 1024 * 2, WSZ_WG = (size_t)4096 * 1024 * 2,
                 WSZ_WB = (size_t)4 * 1024 * 256 * 2, WSZ_WO = (size_t)1024 * 1024 * 2, WSZ_PHI1 = (size_t)2 * 256 * 2048 * 2;
constexpr size_t WO_W1IN = 0, WO_W1OUT = WO_W1IN + WSZ_W1IN, WO_WZ = WO_W1OUT + WSZ_W1OUT, WO_WG = WO_WZ + WSZ_WZ, WO_WB = WO_WG + WSZ_WG, WO_WO = WO_WB + WSZ_WB,
                 WO_W2IN = WO_WO + WSZ_WO, WO_W2OUT = WO_W2IN + WSZ_W1IN, WO_PHI1 = WO_W2OUT + WSZ_W1OUT, W_LAYER = WO_PHI1 + WSZ_PHI1;
constexpr size_t WS_W = 1 * MiB;
constexpr size_t WS_H = WS_W + 2 * W_LAYER;
constexpr size_t WS_BR = WS_H + (size_t)M * 1024 * 2;
constexpr size_t WS_BIG = WS_BR + (size_t)M * 1024 * 2;
constexpr size_t WS_MISC = WS_BIG + (size_t)M * 2816 * 2;
constexpr size_t WS_CUM = WS_MISC + (size_t)M * 16 * 4;
constexpr size_t WS_KC = WS_CUM + (size_t)M * 4 * 4;
constexpr size_t WS_VC = WS_KC + (size_t)2 * 512 * 64 * 2;
constexpr size_t WS_SS = WS_VC + (size_t)2 * 512 * 64 * 2;
constexpr size_t WS_END = WS_SS + (size_t)M * 16 * 4;
static_assert(W_LAYER % 256 == 0 && WS_END <= (size_t)272 * MiB, "ws map");

enum { I_X = 0, I_F1N, I_F1WI, I_F1WO, I_MIXN, I_WIN, I_DQG, I_DKG, I_DLAM, I_FQG, I_FKG, I_FBIAS, I_NQG, I_NKG, I_PE, I_PW1, I_PB1, I_PW2, I_PB2, I_GVG, I_GWS, I_GBS, I_WBR, I_WOUT, I_F2N, I_F2WI, I_F2WO, N_IN };

struct Args { const float* in[N_IN]; float* out; unsigned char* ws; };

constexpr int PTAB_OFF = 147456 + 1024;
DI unsigned long long ptab_get(LAS unsigned char* lds, int i) { unsigned a_ = (unsigned)(uintptr_t)(lds + PTAB_OFF + 8 * i); asm volatile("" : "+s"(a_)); LAS const unsigned* t = (LAS const unsigned*)(uintptr_t)a_;
    const unsigned lo = __builtin_amdgcn_readfirstlane(t[0]), hi = __builtin_amdgcn_readfirstlane(t[1]); return ((unsigned long long)hi << 32) | lo; }
#define GAS __attribute__((address_space(1)))
#define IN(i) ((const float*)(const GAS float*)ptab_get(lds, (i)))
#define OUTP ((float*)(GAS float*)ptab_get(lds, N_IN))
#define WSP ((unsigned char*)(GAS unsigned char*)ptab_get(lds, N_IN + 1))

DI float row_scale16(const float* SS, size_t row, int fq) {
    const f32x4 v = *(const f32x4*)(SS + row * 16 + 4 * fq);
    float s = (v.x + v.y) + (v.z + v.w); s += shx_(s, 16); s += shx_(s, 32);
    return frsq(s * (1.f / D) + EPS);
}
DI void row_scales8(float (&rsv)[2][4], const float* SS, size_t rowb, int fq) {
    f32x4 pv[2][4];
#pragma unroll
    for (int ai = 0; ai < 2; ++ai)
#pragma unroll
        for (int m = 0; m < 4; ++m) pv[ai][m] = *(const f32x4*)(SS + (rowb + ai * 128 + m * 16) * 16 + 4 * fq);
    asm volatile("" ::: "memory");
#pragma unroll
    for (int ai = 0; ai < 2; ++ai)
#pragma unroll
        for (int m = 0; m < 4; ++m) { const f32x4 v = pv[ai][m]; float s = (v.x + v.y) + (v.z + v.w); s += shx_(s, 16); s += shx_(s, 32); rsv[ai][m] = frsq(s * (1.f / D) + EPS); }
}
DI float row_scale_full(const float* SS, size_t row) {
    const f32x4 a = *(const f32x4*)(SS + row * 16), b = *(const f32x4*)(SS + row * 16 + 4), c = *(const f32x4*)(SS + row * 16 + 8), d = *(const f32x4*)(SS + row * 16 + 12);
    const float s = ((a.x + a.y) + (a.z + a.w)) + ((b.x + b.y) + (b.z + b.w)) + ((c.x + c.y) + (c.z + c.w)) + ((d.x + d.y) + (d.z + d.w));
    return frsq(s * (1.f / D) + EPS);
}
struct EpiSwiglu {
    static constexpr bool PERM = true, AFTER_DRAIN = false;
    LAS unsigned char* lds;
    DI void operator()(const f32x4 (&acc)[2][2][4][2], const pg8::Unit& u, int wr, int wc, int fr, int fq) const {
        bf16* O = (bf16*)(WSP + WS_BIG); const float* SS = (const float*)(WSP + WS_SS);
        const int col0 = u.pn * 128 + wc * 32 + 8 * fq;
        float rsv[2][4];
        row_scales8(rsv, SS, (size_t)u.pm * 256 + wr * 64 + fr, fq);
#pragma unroll
        for (int ai = 0; ai < 2; ++ai)
#pragma unroll
            for (int m = 0; m < 4; ++m) {
                const size_t row = (size_t)u.pm * 256 + ai * 128 + wr * 64 + m * 16 + fr;
                float o[8]; const float rs = rsv[ai][m];
#pragma unroll
                for (int n = 0; n < 2; ++n)
#pragma unroll
                    for (int e = 0; e < 4; ++e) { const float a = acc[ai][0][m][n][e] * rs, b = acc[ai][1][m][n][e] * rs; o[4 * n + e] = a * sigmoidf_(a) * b; }
                u32x4 w; w.x = pk2(o[0], o[1]); w.y = pk2(o[2], o[3]); w.z = pk2(o[4], o[5]); w.w = pk2(o[6], o[7]);
                *(u32x4*)(O + row * FF + col0) = w;
            }
    }
};
struct EpiResid {
    static constexpr bool PERM = false, AFTER_DRAIN = false;
    LAS unsigned char* lds; int src, dst; float alpha;
    DI f32x4 ld(const float* xf, const unsigned short* xh, size_t off) const { return unpkh4(*(const u32x2*)(xh + off)); }
    DI void operator()(const f32x4 (&acc)[2][2][4][2], const pg8::Unit& u, int wr, int wc, int fr, int fq) const {
        float* outf = OUTP; const float* xf = IN(I_X);
        const unsigned short* xh = (src == 2) ? (const unsigned short*)(WSP + WS_BR) : (const unsigned short*)outf;
        unsigned short* oh = (dst == 2) ? (unsigned short*)(WSP + WS_BR) : (unsigned short*)outf;
        bf16* XB = (bf16*)(WSP + WS_H); float* SS = (float*)(WSP + WS_SS);
        const int col0 = u.pn * 256 + wc * 32 + 4 * fq;
        const size_t rowb = (size_t)u.pm * 256 + wr * 64 + fr;
        f32x4 bc[2][2], bn[2][2];
#pragma unroll
        for (int bj = 0; bj < 2; ++bj)
#pragma unroll
            for (int n = 0; n < 2; ++n) bc[bj][n] = ld(xf, xh, rowb * D + col0 + bj * 128 + n * 16);
#pragma unroll
        for (int ai = 0; ai < 2; ++ai)
#pragma unroll
            for (int m = 0; m < 4; ++m) {
                const size_t row = rowb + ai * 128 + m * 16;
                if (ai * 4 + m < 7) { const size_t rown = rowb + ((ai * 4 + m + 1) >> 2) * 128 + ((ai * 4 + m + 1) & 3) * 16;
#pragma unroll
                    for (int bj = 0; bj < 2; ++bj)
#pragma unroll
                        for (int n = 0; n < 2; ++n) bn[bj][n] = ld(xf, xh, rown * D + col0 + bj * 128 + n * 16); }
                float ss = 0.f;
#pragma unroll
                for (int bj = 0; bj < 2; ++bj)
#pragma unroll
                    for (int n = 0; n < 2; ++n) { const size_t off = row * D + col0 + bj * 128 + n * 16; const f32x4 o = bc[bj][n] + acc[ai][bj][m][n] * alpha;
                        if (dst == 3) { __builtin_nontemporal_store(o, (f32x4*)(outf + off)); }
                        else { u32x2 hw; hw.x = pkh2(o.x, o.y); hw.y = pkh2(o.z, o.w); *(u32x2*)(oh + off) = hw;
                            ss += (o.x * o.x + o.y * o.y) + (o.z * o.z + o.w * o.w);
                        } }
                if (dst != 3) { ss += shx_(ss, 16); ss += shx_(ss, 32);
                    if (fq == 0) SS[row * 16 + u.pn * 4 + wc] = ss; }
#pragma unroll
                for (int bj = 0; bj < 2; ++bj)
#pragma unroll
                    for (int n = 0; n < 2; ++n) bc[bj][n] = bn[bj][n];
            }
    }
};
struct EpiZ {
    static constexpr bool PERM = true, AFTER_DRAIN = false;
    LAS unsigned char* lds; int l;
    DI void operator()(const f32x4 (&acc)[2][2][4][2], const pg8::Unit& u, int wr, int wc, int fr, int fq) const {
        bf16* Z = (bf16*)(WSP + WS_BIG); float* misc = (float*)(WSP + WS_MISC); const float* SS = (const float*)(WSP + WS_SS);
        const int pn = u.pn;
        int mode = 0; const float* gp = nullptr; float sc = 1.f;
        const float QS64 = 0.125f * LOG2E, QS32 = 0.17677669529663687f * LOG2E;
        if (pn == 0) { mode = 1; gp = IN(I_DQG) + l * 32; sc = QS32; } else if (pn == 1) { mode = 1; gp = IN(I_DKG) + l * 32; } else if (pn == 3) { mode = 2; gp = IN(I_FQG) + l * 64; sc = QS64; } else if (pn == 4) { mode = 2; gp = IN(I_FKG) + l * 64; }
        else if (pn == 6) { mode = 2; gp = IN(I_NQG) + l * 64; sc = QS64; } else if (pn == 7) { if (wc == 2) { mode = 2; gp = IN(I_NKG) + l * 64; } } else if (pn == 8) { if (wc == 0) { mode = 2; gp = IN(I_NKG) + l * 64; } else if (wc == 2) mode = 5; }
        else if (pn == 9) mode = 3; else if (pn == 10) { mode = 4; gp = IN(I_GVG) + l * 256 + 64 * wc; }
        const float* fbias = IN(I_FBIAS) + l * 4;
        float gv[2][2][4];
        {
            const float* gq = gp ? gp : IN(I_GVG);
            const int b0 = 8 * fq, b1 = (mode == 1 ? 0 : 32) + 8 * fq;
            const f32x4 g00 = *(const f32x4*)(gq + b0), g01 = *(const f32x4*)(gq + b0 + 4), g10 = *(const f32x4*)(gq + b1), g11 = *(const f32x4*)(gq + b1 + 4);
            const bool hg = (gp != nullptr);
#pragma unroll
            for (int e = 0; e < 4; ++e) { gv[0][0][e] = hg ? g00[e] * sc : 1.f; gv[0][1][e] = hg ? g01[e] * sc : 1.f; gv[1][0][e] = hg ? g10[e] * sc : 1.f; gv[1][1][e] = hg ? g11[e] * sc : 1.f; }
        }
        float rsv[2][4];
        row_scales8(rsv, SS, (size_t)u.pm * 256 + wr * 64 + fr, fq);
#pragma unroll
        for (int ai = 0; ai < 2; ++ai)
#pragma unroll
            for (int m = 0; m < 4; ++m) {
                const size_t row = (size_t)u.pm * 256 + ai * 128 + wr * 64 + m * 16 + fr;
                float v[2][2][4]; const float rs = rsv[ai][m];
#pragma unroll
                for (int bj = 0; bj < 2; ++bj)
#pragma unroll
                    for (int n = 0; n < 2; ++n)
#pragma unroll
                        for (int e = 0; e < 4; ++e) v[bj][n][e] = acc[ai][bj][m][n][e] * rs;
                if (mode == 3 || mode == 4) {
#pragma unroll
                    for (int bj = 0; bj < 2; ++bj)
#pragma unroll
                        for (int n = 0; n < 2; ++n)
#pragma unroll
                            for (int e = 0; e < 4; ++e) v[bj][n][e] = gelu_tanh(v[bj][n][e]);
                }
                if (mode == 1 || mode == 2 || mode == 4) {
                    float ss[2];
#pragma unroll
                    for (int bj = 0; bj < 2; ++bj) { float s = 0.f;
#pragma unroll
                        for (int n = 0; n < 2; ++n)
#pragma unroll
                            for (int e = 0; e < 4; ++e) s += v[bj][n][e] * v[bj][n][e];
                        s += shx_(s, 16); s += shx_(s, 32); ss[bj] = s; }
                    float r0, r1;
                    if (mode == 1) { r0 = frsq(ss[0] * (1.f / 32.f) + EPS); r1 = frsq(ss[1] * (1.f / 32.f) + EPS); }
                    else { r0 = r1 = frsq((ss[0] + ss[1]) * (1.f / 64.f) + EPS); }
#pragma unroll
                    for (int n = 0; n < 2; ++n)
#pragma unroll
                        for (int e = 0; e < 4; ++e) { v[0][n][e] *= r0 * gv[0][n][e]; v[1][n][e] *= r1 * gv[1][n][e]; }
                }
                if (mode == 5 && fq < 2) {
#pragma unroll
                    for (int n = 0; n < 2; ++n)
#pragma unroll
                        for (int e = 0; e < 4; ++e) { const int d = 8 * fq + 4 * n + e; const float x = v[0][n][e];
                            misc[row * 16 + d] = (d < 4) ? log_sigmoid(x + fbias[d & 3]) : sigmoidf_(x); }
                }
#pragma unroll
                for (int bj = 0; bj < 2; ++bj) { u32x4 w; w.x = pk2(v[bj][0][0], v[bj][0][1]); w.y = pk2(v[bj][0][2], v[bj][0][3]); w.z = pk2(v[bj][1][0], v[bj][1][1]); w.w = pk2(v[bj][1][2], v[bj][1][3]);
                    *(u32x4*)(Z + row * ZW + pn * 256 + wc * 64 + bj * 32 + 8 * fq) = w; }
            }
    }
};

DI int map_ffn_in(int r) { const int t = r >> 8, w = r & 255; return (w < 128) ? 128 * t + w : FF + 128 * t + (w - 128); }
DI int map_z(int r) {
    const int c = (r & ~255) + 64 * ((r >> 5) & 3) + 32 * ((r >> 7) & 1) + (r & 31);
    if (c < 1536) return c;
    if (c < 1792) return 1540 + (c - 1536);
    if (c < 2176) return 1796 + (c - 1792);
    if (c < 2180) return 1536 + (c - 2176);
    if (c < 2192) return c;
    if (c < 2304) return -1;
    if (c < 2560) return 2192 + (c - 2304);
    return 2448 + (c - 2560);
}
DI void conv_matrix(int MAP, const float* W, int pitch, int K, int rows, bf16* WT, LAS float* scr, int gw, int ngw, const float* gain, bool f16) {
    const int lane = otid() & 63;
    const int nblk = rows / 32, nitems = (K / 64) * nblk;
    const int q4 = lane & 7, kk0 = lane >> 3, c = lane & 7;
#define CV_LOAD(dst, item) do { const int kb_ = (item) / nblk, nb_ = (item) % nblk; const int rq_ = 32 * nb_ + 4 * q4; int sq_; \
        if (MAP == 0) sq_ = rq_; else if (MAP == 1) sq_ = map_ffn_in(rq_); else if (MAP == 2) sq_ = map_z(rq_); else sq_ = 2704 + rq_; \
        _Pragma("unroll") for (int i_ = 0; i_ < 8; ++i_) dst[i_] = (sq_ >= 0) ? __builtin_nontemporal_load((const f32x4*)(W + (size_t)(64 * kb_ + kk0 + 8 * i_) * pitch + sq_)) : (f32x4){0.f, 0.f, 0.f, 0.f}; } while (0)
    f32x4 v[8], vn[8];
    int it = gw;
    if (it < nitems) CV_LOAD(v, it);
    while (it < nitems) {
        const int nx = it + ngw;
        if (nx < nitems) CV_LOAD(vn, nx);
        const int kb = it / nblk, nb = it % nblk, k0 = 64 * kb, r0 = 32 * nb;
#pragma unroll
        for (int i = 0; i < 8; ++i) { const float gk = gain ? gain[k0 + kk0 + 8 * i] : 1.f; LAS float* d = scr + (kk0 + 8 * i) * 33 + 4 * q4; d[0] = v[i].x * gk; d[1] = v[i].y * gk; d[2] = v[i].z * gk; d[3] = v[i].w * gk; }
        asm volatile("s_waitcnt lgkmcnt(0)" ::: "memory");
#pragma unroll
        for (int j = 0; j < 4; ++j) { const int n = (lane >> 3) + 8 * j; const LAS float* s = scr + (8 * c) * 33 + n;
            u32x4 o; if (f16) { o.x = pkh2(s[0 * 33], s[1 * 33]); o.y = pkh2(s[2 * 33], s[3 * 33]); o.z = pkh2(s[4 * 33], s[5 * 33]); o.w = pkh2(s[6 * 33], s[7 * 33]); }
            else { o.x = pk2(s[0 * 33], s[1 * 33]); o.y = pk2(s[2 * 33], s[3 * 33]); o.z = pk2(s[4 * 33], s[5 * 33]); o.w = pk2(s[6 * 33], s[7 * 33]); }
            *(u32x4*)(WT + (size_t)(r0 + n) * K + k0 + 8 * c) = o; }
        asm volatile("s_waitcnt lgkmcnt(0)" ::: "memory");
#pragma unroll
        for (int i = 0; i < 8; ++i) v[i] = vn[i];
        it = nx;
    }
#undef CV_LOAD
}
DI float wave_sum(float v) {
#pragma unroll
    for (int o = 1; o < 64; o <<= 1) v += shx_(v, o);
    return v;
}
DI void cast_rows(const float* x, bf16* XB, float* SS, unsigned short* XH, int gw, int ngw) {
    const int lane = otid() & 63;
    for (int m = gw; m < M; m += ngw) {
        const f32x4* xr = (const f32x4*)(x + (size_t)m * D) + lane;
        f32x4 v[4]; float s = 0.f;
#pragma unroll
        for (int j = 0; j < 4; ++j) { v[j] = __builtin_nontemporal_load(xr + 64 * j); s += (v[j].x * v[j].x + v[j].y * v[j].y) + (v[j].z * v[j].z + v[j].w * v[j].w); }
        s = wave_sum(s);
        u32x2* h8 = (u32x2*)(XH + (size_t)m * D) + lane;
#pragma unroll
        for (int j = 0; j < 4; ++j) { u32x2 w; w.x = pkh2(v[j].x, v[j].y); w.y = pkh2(v[j].z, v[j].w); h8[64 * j] = w; }
        if (lane < 16) SS[(size_t)m * 16 + lane] = (lane == 0) ? s : 0.f;
    }
}

constexpr int TROW = 144, TILEB = 64 * TROW;
constexpr int L_KB = 0, L_VB = 2 * TILEB, L_CB = 4 * TILEB, L_IMP = L_CB + 512, L_SEL = L_IMP + 64 * 128 * 4, L_Q = L_SEL + 1024, L_END = L_Q + 64;

struct Soft { float m, l; f32x16 o0, o1; };
DI void soft_init(Soft& s) { s.m = 0.f; s.l = 0.f;
#pragma unroll
    for (int i = 0; i < 16; ++i) { s.o0[i] = 0.f; s.o1[i] = 0.f; } }
DI f32x16 qk_tile(LAS const char* Kt, const bf16x8* qf, int d0, int nd, int r, int h, float cinit) {
    f32x16 s;
#pragma unroll
    for (int i = 0; i < 16; ++i) s[i] = cinit;
#pragma unroll
    for (int ds = 0; ds < 4; ++ds) if (ds >= d0 && ds < d0 + nd) {
        const bf16x8 a = *(LAS const bf16x8*)(Kt + r * TROW + ds * 32 + h * 16);
        s = MFMA32(a, qf[ds], s);
    }
    return s;
}
template <int D0, int ND> DI void qk_pair(f32x16& s0, f32x16& s1, LAS const char* Kt, const bf16x8* qf, int r, int h, float cinit) {
    bf16x8 ka[ND], kb[ND];
#pragma unroll
    for (int ds = 0; ds < ND; ++ds) { ka[ds] = *(LAS const bf16x8*)(Kt + r * TROW + (D0 + ds) * 32 + h * 16); kb[ds] = *(LAS const bf16x8*)(Kt + (32 + r) * TROW + (D0 + ds) * 32 + h * 16); }
    asm volatile("" ::: "memory");
#pragma unroll
    for (int i = 0; i < 16; ++i) { s0[i] = cinit; s1[i] = cinit; }
#pragma unroll
    for (int ds = 0; ds < ND; ++ds) { s0 = MFMA32(ka[ds], qf[D0 + ds], s0); s1 = MFMA32(kb[ds], qf[D0 + ds], s1); }
}
constexpr float SOFT_THR = 6.0f;
template <bool TRACK = true> DI void soft_pre(Soft& st, f32x16& s0, f32x16& s1, bf16x8* p) {
  if (TRACK) {
    float ra = fmaxf(fmaxf(s0[0], s0[1]), s1[0]), rb = fmaxf(fmaxf(s0[2], s0[3]), s1[1]);
    ra = fmaxf(fmaxf(ra, s1[2]), s1[3]);
#pragma unroll
    for (int i = 4; i < 16; i += 4) { ra = fmaxf(fmaxf(ra, s0[i]), s0[i + 1]); rb = fmaxf(fmaxf(rb, s0[i + 2]), s0[i + 3]); ra = fmaxf(fmaxf(ra, s1[i]), s1[i + 1]); rb = fmaxf(fmaxf(rb, s1[i + 2]), s1[i + 3]); }
    float rm = fmaxf(ra, rb);
    rm = fmaxf(rm, shx_(rm, 32));
    if (__any(rm > SOFT_THR)) {
        const float d = fmaxf(rm, 0.f), f = fexp2(-d);
        st.m += d; st.l *= f;
        s0 = s0 - d; s1 = s1 - d; st.o0 = st.o0 * f; st.o1 = st.o1 * f;
    }
  }
#pragma unroll
    for (int i = 0; i < 16; ++i) { s0[i] = fexp2(s0[i]); s1[i] = fexp2(s1[i]); }
    {
        f32x16 t = s0 + s1;
        const float a0 = (t[0] + t[1]) + (t[2] + t[3]), a1 = (t[4] + t[5]) + (t[6] + t[7]), a2 = (t[8] + t[9]) + (t[10] + t[11]), a3 = (t[12] + t[13]) + (t[14] + t[15]);
        st.l += (a0 + a1) + (a2 + a3);
    }
    p[0] = pack8(s0[0], s0[1], s0[2], s0[3], s0[4], s0[5], s0[6], s0[7]);
    p[1] = pack8(s0[8], s0[9], s0[10], s0[11], s0[12], s0[13], s0[14], s0[15]);
    p[2] = pack8(s1[0], s1[1], s1[2], s1[3], s1[4], s1[5], s1[6], s1[7]);
    p[3] = pack8(s1[8], s1[9], s1[10], s1[11], s1[12], s1[13], s1[14], s1[15]);
}
DI void soft_step(Soft& st, f32x16& s0, f32x16& s1, LAS const char* Vt, int lane) {
    const int g = (lane >> 4) & 1, h = lane >> 5, q = (lane & 15) >> 2, pp = lane & 3;
    LAS const char* vb = Vt + (4 * h + q) * TROW + (16 * g + 4 * pp) * 2;
    bf16x8 va[2], vbq[2];
#pragma unroll
    for (int ks = 0; ks < 2; ++ks) { va[ks] = cat8(tr_read(vb + (16 * ks) * TROW), tr_read(vb + (16 * ks + 8) * TROW)); vbq[ks] = cat8(tr_read(vb + (16 * ks) * TROW + 64), tr_read(vb + (16 * ks + 8) * TROW + 64)); }
    asm volatile("" ::: "memory");
    bf16x8 p[4]; soft_pre(st, s0, s1, p);
    bf16x8 vc[2], vd[2];
#pragma unroll
    for (int ks = 2; ks < 4; ++ks) { vc[ks - 2] = cat8(tr_read(vb + (16 * ks) * TROW), tr_read(vb + (16 * ks + 8) * TROW)); vd[ks - 2] = cat8(tr_read(vb + (16 * ks) * TROW + 64), tr_read(vb + (16 * ks + 8) * TROW + 64)); }
    asm volatile("" ::: "memory");
#pragma unroll
    for (int ks = 0; ks < 2; ++ks) { st.o0 = MFMA32(va[ks], p[ks], st.o0); st.o1 = MFMA32(vbq[ks], p[ks], st.o1); }
#pragma unroll
    for (int ks = 0; ks < 2; ++ks) { st.o0 = MFMA32(vc[ks], p[2 + ks], st.o0); st.o1 = MFMA32(vd[ks], p[2 + ks], st.o1); }
}
DI void pv_step2(Soft& sa, Soft& sb, const bf16x8* pa, const bf16x8* pb, LAS const char* Vt, int lane) {
    const int g = (lane >> 4) & 1, h = lane >> 5, q = (lane & 15) >> 2, pp = lane & 3;
    LAS const char* vb = Vt + (4 * h + q) * TROW + (16 * g + 4 * pp) * 2;
#pragma unroll
    for (int ks = 0; ks < 4; ++ks) {
        const bf16x8 v0 = cat8(tr_read(vb + (16 * ks) * TROW), tr_read(vb + (16 * ks + 8) * TROW));
        const bf16x8 v1 = cat8(tr_read(vb + (16 * ks) * TROW + 64), tr_read(vb + (16 * ks + 8) * TROW + 64));
        sa.o0 = MFMA32(v0, pa[ks], sa.o0); sa.o1 = MFMA32(v1, pa[ks], sa.o1);
        sb.o0 = MFMA32(v0, pb[ks], sb.o0); sb.o1 = MFMA32(v1, pb[ks], sb.o1);
    }
}
DI float gain_max(const float* g, int n) { float m = 0.f; for (int d = 0; d < n; ++d) m = fmaxf(m, fabsf(g[d])); return m; }
DI u32x4 tile_ld(const bf16* src, int pitch, int tid) { return *(const u32x4*)(src + (size_t)(tid >> 3) * pitch + (tid & 7) * 8); }
DI void tile_st(LAS char* dst, u32x4 v, int tid) { *(LAS u32x4*)(dst + (tid >> 3) * TROW + (tid & 7) * 16) = v; }

DI void store_o(bf16* dst, const f32x16& o0, const f32x16& o1, float sc, int h) {
#pragma unroll
    for (int g = 0; g < 4; ++g) {
        u32x2 w0, w1; w0.x = pk2(o0[4 * g] * sc, o0[4 * g + 1] * sc); w0.y = pk2(o0[4 * g + 2] * sc, o0[4 * g + 3] * sc);
        w1.x = pk2(o1[4 * g] * sc, o1[4 * g + 1] * sc); w1.y = pk2(o1[4 * g + 2] * sc, o1[4 * g + 3] * sc);
        *(u32x2*)(dst + 8 * g + 4 * h) = w0; *(u32x2*)(dst + 32 + 8 * g + 4 * h) = w1;
    }
}

template <bool DIFF, bool TRACK = true> DI void attn_unit(int b, int hd, int qb, const bf16* Z, const float* CUM, bf16* BR, float lam, float lam_init, const float* kgain, LAS char* lds) {
    const int tid = otid(), lane = tid & 63, wid = tid >> 6, r = lane & 31, h = lane >> 5;
    const size_t rb = (size_t)b * T;
    const int q0 = qb * 256, qrow = q0 + wid * 32 + r;
    const int qcol = (DIFF ? 0 : 768) + hd * 64, kcol = (DIFF ? 256 : 1024) + hd * 64, vcol = (DIFF ? 512 : 1280) + hd * 64;
    bf16x8 qf[4];
#pragma unroll
    for (int ds = 0; ds < 4; ++ds) qf[ds] = *(const bf16x8*)(Z + (rb + qrow) * ZW + qcol + ds * 16 + h * 8);
    float cq = 0.f, thr_max = 0.f;
    if (!DIFF) {
        cq = CUM[(rb + qrow) * 4 + hd] * LOG2E;
        float gmax = 0.f; for (int d = 0; d < 64; ++d) gmax = fmaxf(gmax, fabsf(kgain[d]));
        float qn = 0.f;
#pragma unroll
        for (int ds = 0; ds < 4; ++ds) { const u32x4 w = __builtin_bit_cast(u32x4, qf[ds]);
            qn += bflo(w.x) * bflo(w.x) + bfhi(w.x) * bfhi(w.x) + bflo(w.y) * bflo(w.y) + bfhi(w.y) * bfhi(w.y) + bflo(w.z) * bflo(w.z) + bfhi(w.z) * bfhi(w.z) + bflo(w.w) * bflo(w.w) + bfhi(w.w) * bfhi(w.w); }
        qn += shx_(qn, 32);
        const float B = sqrtf(qn) * 8.08f * gmax;
        float thr = cq + 2.f * B + 48.f;
#pragma unroll
        for (int o = 1; o < 64; o <<= 1) thr = fmaxf(thr, shx_(thr, o));
        LAS float* wt = (LAS float*)(lds + L_Q + 16);
        if (lane == 0) wt[wid] = thr;
        __syncthreads();
        thr_max = wt[0];
#pragma unroll
        for (int w = 1; w < 8; ++w) thr_max = fmaxf(thr_max, wt[w]);
    }
    Soft s1, s2; soft_init(s1); if (DIFF) soft_init(s2);
    const int nt = (q0 + 256) / 64;
    const bf16* Kg = Z + rb * ZW + kcol; const bf16* Vg = Z + rb * ZW + vcol;
    u32x4 kr = tile_ld(Kg + (size_t)(nt - 1) * 64 * ZW, ZW, tid), vr = tile_ld(Vg + (size_t)(nt - 1) * 64 * ZW, ZW, tid); float cr = 0.f;
    if (!DIFF && tid < 64) cr = CUM[(rb + (nt - 1) * 64 + tid) * 4 + hd] * LOG2E;
    for (int it = 0; it < nt; ++it) {
        const int kt = nt - 1 - it, buf = it & 1;
        LAS char* Kt = lds + L_KB + buf * TILEB; LAS char* Vt = lds + L_VB + buf * TILEB; LAS float* cb = (LAS float*)(lds + L_CB) + buf * 64;
        tile_st(Kt, kr, tid); tile_st(Vt, vr, tid); if (!DIFF && tid < 64) cb[tid] = cr;
        __syncthreads();
        if (!DIFF) { if (cb[63] > thr_max) break; }
        if (kt > 0) { kr = tile_ld(Kg + (size_t)(kt - 1) * 64 * ZW, ZW, tid); vr = tile_ld(Vg + (size_t)(kt - 1) * 64 * ZW, ZW, tid); if (!DIFF && tid < 64) cr = CUM[(rb + (kt - 1) * 64 + tid) * 4 + hd] * LOG2E; }
        const bool diag = (kt * 64 + 63 > q0 + wid * 32);
        if (kt * 64 > q0 + wid * 32 + 31) continue;
        if (DIFF) {
            bf16x8 p1[4], p2[4];
#pragma unroll
            for (int mp = 0; mp < 2; ++mp) {
                const float ci = -(mp == 0 ? s1.m : s2.m);
                f32x16 a0, a1; if (mp == 0) qk_pair<0, 2>(a0, a1, Kt, qf, r, h, ci); else qk_pair<2, 2>(a0, a1, Kt, qf, r, h, ci);
                if (diag) {
#pragma unroll
                    for (int i = 0; i < 16; ++i) { const int key = kt * 64 + crow(i, h); if (key > qrow) a0[i] = -INFINITY; if (key + 32 > qrow) a1[i] = -INFINITY; }
                }
                soft_pre<TRACK>(mp == 0 ? s1 : s2, a0, a1, mp == 0 ? p1 : p2);
            }
            pv_step2(s1, s2, p1, p2, Vt, lane);
        } else {
            const float ci = cq - s1.m;
            f32x16 a0, a1; qk_pair<0, 4>(a0, a1, Kt, qf, r, h, ci);
#pragma unroll
            for (int g = 0; g < 4; ++g) { const f32x4 c0 = *(LAS const f32x4*)(cb + 8 * g + 4 * h), c1 = *(LAS const f32x4*)(cb + 32 + 8 * g + 4 * h);
#pragma unroll
                for (int e = 0; e < 4; ++e) { a0[4 * g + e] -= c0[e]; a1[4 * g + e] -= c1[e]; } }
            if (diag) {
#pragma unroll
                for (int i = 0; i < 16; ++i) { const int key = kt * 64 + crow(i, h); if (key > qrow) a0[i] = -INFINITY; if (key + 32 > qrow) a1[i] = -INFINITY; }
            }
            soft_step(s1, a0, a1, Vt, lane);
        }
    }
    float l1 = s1.l + shx_(s1.l, 32); const float i1 = 1.f / fmaxf(l1, 1e-30f);
    if (DIFF) {
        float l2 = s2.l + shx_(s2.l, 32); const float i2 = lam / fmaxf(l2, 1e-30f);
        float ss = 0.f;
#pragma unroll
        for (int i = 0; i < 16; ++i) { s1.o0[i] = s1.o0[i] * i1 - s2.o0[i] * i2; s1.o1[i] = s1.o1[i] * i1 - s2.o1[i] * i2; ss += s1.o0[i] * s1.o0[i] + s1.o1[i] * s1.o1[i]; }
        ss += shx_(ss, 32);
        const float rr = frsq(ss * (1.f / 64.f) + EPS) * (1.f - lam_init);
        store_o(BR + (rb + qrow) * 1024 + hd * 64, s1.o0, s1.o1, rr, h);
    } else {
        store_o(BR + (rb + qrow) * 1024 + 256 + hd * 64, s1.o0, s1.o1, i1, h);
    }
    __syncthreads();
}

template <int MODE> DI void nsa_loop(Soft& st, const bf16x8* qf, const bf16* Kg, const bf16* Vg, int pitch, int j0, int j1, int tq, int t0, LAS const unsigned* bm, LAS char* lds) {
    const int tid = otid(), lane = tid & 63, r = lane & 31, h = lane >> 5;
    u32x4 kr = tile_ld(Kg + (size_t)j0 * 64 * pitch, pitch, tid), vr = tile_ld(Vg + (size_t)j0 * 64 * pitch, pitch, tid);
    for (int j = j0; j <= j1; ++j) {
        const int buf = (j - j0) & 1;
        LAS char* Kt = lds + L_KB + buf * TILEB; LAS char* Vt = lds + L_VB + buf * TILEB;
        tile_st(Kt, kr, tid); tile_st(Vt, vr, tid);
        __syncthreads();
        if (j < j1) { kr = tile_ld(Kg + (size_t)(j + 1) * 64 * pitch, pitch, tid); vr = tile_ld(Vg + (size_t)(j + 1) * 64 * pitch, pitch, tid); }
        float ci = -st.m; bool need_mask;
        if (MODE == 1) { const bool sel = (bm[j >> 5] >> (j & 31)) & 1u; if (!__any(sel)) continue;
            if (!sel) ci = -INFINITY; need_mask = (j == j1); }
        else if (MODE == 0) need_mask = (16 * (j * 64 + 63) + 31 > t0);
        else need_mask = (j == j1) || (j + 8 == j1);
        f32x16 a0, a1; qk_pair<0, 4>(a0, a1, Kt, qf, r, h, ci);
        if (need_mask) {
            if (MODE == 0) {
#pragma unroll
                for (int i = 0; i < 16; ++i) { const int n = j * 64 + crow(i, h); if (16 * n + 31 > tq) a0[i] = -INFINITY; if (16 * (n + 32) + 31 > tq) a1[i] = -INFINITY; }
            } else if (MODE == 1) {
#pragma unroll
                for (int i = 0; i < 16; ++i) { const int key = j * 64 + crow(i, h); if (key > tq) a0[i] = -INFINITY; if (key + 32 > tq) a1[i] = -INFINITY; }
            } else {
#pragma unroll
                for (int i = 0; i < 16; ++i) { const int key = j * 64 + crow(i, h); if (key > tq || key < tq - 511) a0[i] = -INFINITY; if (key + 32 > tq || key + 32 < tq - 511) a1[i] = -INFINITY; }
            }
        }
        soft_step(st, a0, a1, Vt, lane);
    }
    __syncthreads();
}
DI void nsa_unit(int b, int cur, const bf16* Z, const bf16* KC, const bf16* VC, const float* MISC, bf16* BR, LAS char* lds) {
    const int tid = otid(), lane = tid & 63, wid = tid >> 6, r = lane & 31, h = lane >> 5;
    const size_t rb = (size_t)b * T;
    const int t0 = cur * 64, ql = wid * 8 + (r >> 2), tq = t0 + ql, hd = r & 3;
    bf16x8 qf[4];
#pragma unroll
    for (int ds = 0; ds < 4; ++ds) qf[ds] = *(const bf16x8*)(Z + (rb + tq) * ZW + 1536 + hd * 64 + ds * 16 + h * 8);
    LAS float* imp = (LAS float*)(lds + L_IMP);
    for (int i = tid; i < 64 * 128; i += NTHR) imp[i] = 0.f;
    float oc0[16], oc1[16];
    const float g0 = MISC[(rb + tq) * 16 + 4 + hd * 3 + 0], g1 = MISC[(rb + tq) * 16 + 4 + hd * 3 + 1], g2 = MISC[(rb + tq) * 16 + 4 + hd * 3 + 2];
    const bf16* KCb = KC + (size_t)b * 512 * 64; const bf16* VCb = VC + (size_t)b * 512 * 64;
    const int ncmp = (cur >= 1 || true) ? (4 * cur + 3) : 0;
    const int jc1 = (ncmp - 1) / 64;
    Soft sc; soft_init(sc);
    nsa_loop<0>(sc, qf, KCb, VCb, 64, 0, jc1, tq, t0, nullptr, lds);
    const float lc = sc.l + shx_(sc.l, 32); const float ilc = 1.f / fmaxf(lc, 1e-30f);
#pragma unroll
    for (int i = 0; i < 16; ++i) { oc0[i] = sc.o0[i] * ilc * g0; oc1[i] = sc.o1[i] * ilc * g0; }
    {
        const float mfin = sc.m;
        u32x4 kr = tile_ld(KCb, 64, tid);
        for (int j = 0; j <= jc1; ++j) {
            const int buf = j & 1; LAS char* Kt = lds + L_KB + buf * TILEB;
            tile_st(Kt, kr, tid);
            __syncthreads();
            if (j < jc1) kr = tile_ld(KCb + (size_t)(j + 1) * 64 * 64, 64, tid);
#pragma unroll
            for (int half = 0; half < 2; ++half) {
                f32x16 a = qk_tile(Kt + half * 32 * TROW, qf, 0, 4, r, h, -mfin);
#pragma unroll
                for (int g = 0; g < 4; ++g) {
                    float pv[4];
#pragma unroll
                    for (int e = 0; e < 4; ++e) { const int n = j * 64 + half * 32 + 8 * g + 4 * h + e; pv[e] = (16 * n + 31 > tq) ? 0.f : fexp2(a[4 * g + e]) * ilc; }
                    float G = (pv[0] + pv[1]) + (pv[2] + pv[3]), L = pv[3];
                    G += shx_(G, 1); G += shx_(G, 2); L += shx_(L, 1); L += shx_(L, 2);
                    const int jb = j * 16 + half * 8 + 2 * g + h;
                    if (hd == 0) { if (jb < 128) __hip_atomic_fetch_add(&imp[ql * 128 + jb], G, __ATOMIC_RELAXED, __HIP_MEMORY_SCOPE_WORKGROUP); if (jb + 1 < 128) __hip_atomic_fetch_add(&imp[ql * 128 + jb + 1], L, __ATOMIC_RELAXED, __HIP_MEMORY_SCOPE_WORKGROUP); }
                }
            }
        }
        __syncthreads();
    }
    LAS unsigned* selm = (LAS unsigned*)(lds + L_SEL);
    {
        const int qi = lane >> 3, sub = lane & 7, qq = wid * 8 + qi, t = t0 + qq;
        LAS unsigned* kp = (LAS unsigned*)imp + qq * 128 + sub * 16;
#pragma unroll
        for (int c4 = 0; c4 < 4; ++c4) {
            const f32x4 v = *(LAS const f32x4*)((LAS const float*)kp + 4 * c4); u32x4 k;
#pragma unroll
            for (int e = 0; e < 4; ++e) { const int j = sub * 16 + 4 * c4 + e; const bool forced = (j == 0) || (j == cur) || (j == cur - 1); const bool valid = (j * 64 <= t);
                const float x = forced ? 1.0e4f : v[e]; k[e] = (forced || valid) ? (__float_as_uint(fmaxf(x, 0.f)) + 1u) : 0u; }
            *(LAS u32x4*)(kp + 4 * c4) = k;
        }
        unsigned bm0 = 0, bm1 = 0, bm2 = 0, bm3 = 0;
        for (int it = 0; it < 16; ++it) {
            unsigned bu = 0; int bj = 0;
#pragma unroll
            for (int c4 = 0; c4 < 4; ++c4) { const u32x4 k = *(LAS const u32x4*)(kp + 4 * c4);
#pragma unroll
                for (int e = 0; e < 4; ++e) if (k[e] > bu) { bu = k[e]; bj = sub * 16 + 4 * c4 + e; } }
#pragma unroll
            for (int o = 1; o < 8; o <<= 1) { const unsigned ou = shx_(bu, o); const int oj = shx_(bj, o); if (ou > bu || (ou == bu && oj < bj)) { bu = ou; bj = oj; } }
            if (bu != 0u) {
                if ((bj >> 4) == sub) ((LAS unsigned*)imp)[qq * 128 + bj] = 0u;
                const unsigned bit = 1u << (bj & 31);
                if (bj < 32) bm0 |= bit; else if (bj < 64) bm1 |= bit; else if (bj < 96) bm2 |= bit; else bm3 |= bit;
            }
        }
        if (sub == 0) { selm[qq * 4 + 0] = bm0; selm[qq * 4 + 1] = bm1; selm[qq * 4 + 2] = bm2; selm[qq * 4 + 3] = bm3; }
    }
    __syncthreads();
    LAS const unsigned* bm = selm + ql * 4;
    {
        Soft ss; soft_init(ss);
        nsa_loop<1>(ss, qf, Z + rb * ZW + 1920, Z + rb * ZW + 1984, ZW, 0, cur, tq, t0, bm, lds);
        const float l = ss.l + shx_(ss.l, 32); const float il = g1 / fmaxf(l, 1e-30f);
#pragma unroll
        for (int i = 0; i < 16; ++i) { oc0[i] += ss.o0[i] * il; oc1[i] += ss.o1[i] * il; }
    }
    {
        Soft sw; soft_init(sw);
        const int jw0 = cur >= 8 ? cur - 8 : 0;
        nsa_loop<2>(sw, qf, Z + rb * ZW + 2048, Z + rb * ZW + 2112, ZW, jw0, cur, tq, t0, nullptr, lds);
        const float l = sw.l + shx_(sw.l, 32); const float il = g2 / fmaxf(l, 1e-30f);
#pragma unroll
        for (int i = 0; i < 16; ++i) { oc0[i] += sw.o0[i] * il; oc1[i] += sw.o1[i] * il; }
    }
    {
        bf16* dst = BR + (rb + tq) * 1024 + 512 + hd * 64;
#pragma unroll
        for (int g = 0; g < 4; ++g) {
            u32x2 w0, w1; w0.x = pk2(oc0[4 * g], oc0[4 * g + 1]); w0.y = pk2(oc0[4 * g + 2], oc0[4 * g + 3]);
            w1.x = pk2(oc1[4 * g], oc1[4 * g + 1]); w1.y = pk2(oc1[4 * g + 2], oc1[4 * g + 3]);
            *(u32x2*)(dst + 8 * g + 4 * h) = w0; *(u32x2*)(dst + 32 + 8 * g + 4 * h) = w1;
        }
    }
    __syncthreads();
}

DI void gmlp_unit(int b, int ch, int g, int l, const bf16* Z, const float* WS_, const float* BS_, bf16* BR, LAS char* lds) {
    const int tid = otid(), lane = tid & 63, wid = tid >> 6, r = lane & 31, h = lane >> 5;
    const size_t row0 = (size_t)b * T + ch * 128;
    const bf16* Vg = Z + row0 * ZW + 2560 + 64 * g;
    const int dt = wid & 1, tt = wid >> 1, t = 32 * tt + r;
    const float* Wr = WS_ + ((size_t)(l * 4 + g) * 128 + t) * 128;
    u32x4 vst[2];
#pragma unroll
    for (int u = 0; u < 2; ++u) { const int c = tid + 512 * u; vst[u] = *(const u32x4*)(Vg + (size_t)(c >> 3) * ZW + (c & 7) * 8); }
    const int nk = (32 * tt + 31) / 16 + 1;
    f32x4 wl0[8], wl1[8];
#pragma unroll
    for (int ks = 0; ks < 8; ++ks) if (ks < nk) { wl0[ks] = *(const f32x4*)(Wr + 16 * ks + 8 * h); wl1[ks] = *(const f32x4*)(Wr + 16 * ks + 8 * h + 4); }
    const float bias = BS_[(size_t)(l * 4 + g) * 128 + t];
    const bf16* ug = Z + (row0 + t) * ZW + 2304 + 64 * g + 32 * dt;
    u32x2 uu[4];
#pragma unroll
    for (int k = 0; k < 4; ++k) uu[k] = *(const u32x2*)(ug + 8 * k + 4 * h);
#pragma unroll
    for (int u = 0; u < 2; ++u) { const int c = tid + 512 * u; *(LAS u32x4*)(lds + (c >> 3) * TROW + (c & 7) * 16) = vst[u]; }
    __syncthreads();
    f32x16 acc;
#pragma unroll
    for (int i = 0; i < 16; ++i) acc[i] = 0.f;
    const int gg = (lane >> 4) & 1, q = (lane & 15) >> 2, pp = lane & 3;
    LAS const char* vb = lds + (8 * h + q) * TROW + (32 * dt + 16 * gg + 4 * pp) * 2;
#pragma unroll
    for (int ks = 0; ks < 8; ++ks) if (ks < nk) {
        const bf16x8 a = cat8(tr_read(vb + (16 * ks) * TROW), tr_read(vb + (16 * ks + 4) * TROW));
        float wv[8] = {wl0[ks].x, wl0[ks].y, wl0[ks].z, wl0[ks].w, wl1[ks].x, wl1[ks].y, wl1[ks].z, wl1[ks].w};
#pragma unroll
        for (int j = 0; j < 8; ++j) if (16 * ks + 8 * h + j > t) wv[j] = 0.f;
        const bf16x8 bb = pack8(wv[0], wv[1], wv[2], wv[3], wv[4], wv[5], wv[6], wv[7]);
        acc = MFMA32(a, bb, acc);
    }
    bf16* dst = BR + (row0 + t) * 1024 + 768 + 64 * g + 32 * dt;
#pragma unroll
    for (int k = 0; k < 4; ++k) {
        u32x2 w; w.x = pk2(bflo(uu[k].x) * (acc[4 * k] + bias), bfhi(uu[k].x) * (acc[4 * k + 1] + bias)); w.y = pk2(bflo(uu[k].y) * (acc[4 * k + 2] + bias), bfhi(uu[k].y) * (acc[4 * k + 3] + bias));
        *(u32x2*)(dst + 8 * k + 4 * h) = w;
    }
    __syncthreads();
}

DI void cumsum_unit(int b, int hd, const float* MISC, float* CUM, LAS char* lds) {
    const int tid = otid(), lane = tid & 63, wid = tid >> 6;
    const size_t rb = (size_t)b * T;
    float v[16]; float run = 0.f;
#pragma unroll
    for (int j = 0; j < 16; ++j) { run += MISC[(rb + tid * 16 + j) * 16 + hd]; v[j] = run; }
    float inc = run;
#pragma unroll
    for (int o = 1; o < 64; o <<= 1) { const float n = shup_(inc, o); if (lane >= o) inc += n; }
    LAS float* wt = (LAS float*)lds;
    if (lane == 63) wt[wid] = inc;
    __syncthreads();
    float off = inc - run;
    for (int w = 0; w < wid; ++w) off += wt[w];
#pragma unroll
    for (int j = 0; j < 16; ++j) CUM[(rb + tid * 16 + j) * 4 + hd] = v[j] + off;
    __syncthreads();
}

DI void compress_unit(int l, int s, int b, int nb, const bf16* Z, const bf16* phi1t, const float* pe, const float* b1, const float* w2, const float* b2, const float* nkg, bf16* OUT, LAS char* lds) {
    const int tid = otid(), lane = tid & 63, wid = tid >> 6, r = lane & 31, h = lane >> 5;
    const size_t rb = (size_t)b * T;
    const bf16* xg = Z + rb * ZW + (s == 0 ? 1792 : 1856);
    const int n = 32 * nb + r, c = 32 * wid + r;
    const bf16* w1 = phi1t + (size_t)c * 2048;
    f32x16 acc;
#pragma unroll
    for (int i = 0; i < 16; ++i) acc[i] = 0.f;
#pragma unroll 8
    for (int ks = 0; ks < 128; ++ks) {
        const int p = ks >> 2, d0 = 16 * (ks & 3) + 8 * h;
        int tok = 16 * n + p; tok = tok > T - 1 ? T - 1 : tok;
        const u32x4 xa = *(const u32x4*)(xg + (size_t)tok * ZW + d0);
        const f32x4 p0 = *(const f32x4*)(pe + p * 64 + d0), p1 = *(const f32x4*)(pe + p * 64 + d0 + 4);
        const bf16x8 a = pack8(bflo(xa.x) + p0.x, bfhi(xa.x) + p0.y, bflo(xa.y) + p0.z, bfhi(xa.y) + p0.w, bflo(xa.z) + p1.x, bfhi(xa.z) + p1.y, bflo(xa.w) + p1.z, bfhi(xa.w) + p1.w);
        const bf16x8 bb = *(const bf16x8*)(w1 + 16 * ks + 8 * h);
        acc = MFMA32(a, bb, acc);
    }
    LAS bf16* hid = (LAS bf16*)lds; LAS float* ob = (LAS float*)(lds + 18432);
    const float bb1 = b1[c];
#pragma unroll
    for (int i = 0; i < 16; ++i) { const float v = gelu_tanh(acc[i] + bb1); hid[crow(i, h) * 264 + c] = (bf16)(pk2(v, 0.f) & 0xffffu); }
    __syncthreads();
    if (wid < 2) {
        const int e = 32 * wid + r;
        f32x16 a2;
#pragma unroll
        for (int i = 0; i < 16; ++i) a2[i] = 0.f;
        for (int ks = 0; ks < 16; ++ks) {
            const bf16x8 a = *(LAS const bf16x8*)((LAS const char*)hid + r * 528 + (16 * ks + 8 * h) * 2);
            float wv[8];
#pragma unroll
            for (int j = 0; j < 8; ++j) wv[j] = w2[(size_t)(16 * ks + 8 * h + j) * 64 + e];
            const bf16x8 bb = pack8(wv[0], wv[1], wv[2], wv[3], wv[4], wv[5], wv[6], wv[7]);
            a2 = MFMA32(a, bb, a2);
        }
        const float bb2 = b2[e];
#pragma unroll
        for (int i = 0; i < 16; ++i) ob[crow(i, h) * 65 + e] = a2[i] + bb2;
    }
    __syncthreads();
    {
        const int nl = tid >> 4, e4 = (tid & 15) * 4;
        float v[4];
#pragma unroll
        for (int j = 0; j < 4; ++j) v[j] = ob[nl * 65 + e4 + j];
        if (s == 0) {
            float ss = v[0] * v[0] + v[1] * v[1] + v[2] * v[2] + v[3] * v[3];
            ss += shx_(ss, 1); ss += shx_(ss, 2); ss += shx_(ss, 4); ss += shx_(ss, 8);
            const float rr = frsq(ss * (1.f / 64.f) + EPS);
#pragma unroll
            for (int j = 0; j < 4; ++j) v[j] *= rr * nkg[e4 + j];
        }
        const int nn = 32 * nb + nl;
        if (nn > 510) { v[0] = v[1] = v[2] = v[3] = 0.f; }
        u32x2 w; w.x = pk2(v[0], v[1]); w.y = pk2(v[2], v[3]);
        *(u32x2*)(OUT + ((size_t)b * 512 + nn) * 64 + e4) = w;
    }
    __syncthreads();
}

DI void merge_unit(int pm, int pn, const bf16* H, const bf16* BR, const bf16* Wg, const bf16* Wb, bf16* U, const float* SS, LAS char* lds) {
    const int tid = otid(), lane = tid & 63, wid = __builtin_amdgcn_readfirstlane(tid >> 6), r = lane & 31, h = lane >> 5, wr = wid >> 1, wc = wid & 1;
    const size_t row0 = (size_t)pm * 256; const int c0 = pn * 128;
    f32x16 A[2][2], Uacc[2][2];
    unsigned S[2][2][8];
#pragma unroll
    for (int a = 0; a < 2; ++a)
#pragma unroll
        for (int t = 0; t < 2; ++t)
#pragma unroll
            for (int i = 0; i < 16; ++i) { A[a][t][i] = 0.f; Uacc[a][t][i] = 0.f; }
    const float rs0 = row_scale_full(SS, row0 + 64 * wr + r), rs1 = row_scale_full(SS, row0 + 64 * wr + 32 + r);
    constexpr int AT = 256 * 128, BT = 128 * 128, BUFB = AT + BT, NS = 80;
    const int srow = lane >> 3, sch = lane & 7;
#define MG_DMA(s, slot) do { const int i_ = (s) / 20, j_ = (s) % 20; const bf16 *ap, *bp; int pb; \
        if (j_ < 16) { ap = H + row0 * 1024 + j_ * 64; bp = Wg + ((size_t)i_ * 1024 + c0) * 1024 + j_ * 64; pb = 1024; } \
        else { ap = BR + row0 * 1024 + 256 * i_ + (j_ - 16) * 64; bp = Wb + ((size_t)i_ * 1024 + c0) * 256 + (j_ - 16) * 64; pb = 256; } \
        LAS char* as_ = lds + (slot) * BUFB; LAS char* bs_ = as_ + AT; \
        _Pragma("unroll") for (int u_ = 0; u_ < 4; ++u_) { const int R_ = 8 * (wid * 4 + u_) + srow; const int ch_ = sch ^ ((R_ >> 1) & 7); \
            __builtin_amdgcn_global_load_lds((const unsigned*)(ap + (size_t)R_ * 1024 + ch_ * 8), (LAS unsigned*)(as_ + (wid * 4 + u_) * 1024), 16, 0, 0); } \
        _Pragma("unroll") for (int u_ = 0; u_ < 2; ++u_) { const int R_ = 8 * (wid * 2 + u_) + srow; const int ch_ = sch ^ ((R_ >> 1) & 7); \
            __builtin_amdgcn_global_load_lds((const unsigned*)(bp + (size_t)R_ * pb + ch_ * 8), (LAS unsigned*)(bs_ + (wid * 2 + u_) * 1024), 16, 0, 0); } } while (0)
#define MG_FRAG(base, R, c) (*(LAS const bf16x8*)((base) + (R) * 128 + (((c) ^ (((R) >> 1) & 7)) * 16)))
#define MG_STEP(MM) do { \
        if (s + 1 < NS) asm volatile("s_waitcnt vmcnt(6)" ::: "memory"); else asm volatile("s_waitcnt vmcnt(0)" ::: "memory"); \
        __builtin_amdgcn_s_barrier(); asm volatile("" ::: "memory"); \
        if (s + 2 < NS) MG_DMA(s + 2, sl2); \
        { LAS const char* as_ = lds + sl0 * BUFB; LAS const char* bs_ = as_ + AT; \
        __builtin_amdgcn_s_setprio(1); \
        _Pragma("unroll") for (int ks_ = 0; ks_ < 4; ++ks_) { const int c_ = 2 * ks_ + h; \
            const bf16x8 w0_ = MG_FRAG(bs_, 64 * wc + r, c_); const bf16x8 w1_ = MG_FRAG(bs_, 64 * wc + 32 + r, c_); \
            const bf16x8 h0_ = MG_FRAG(as_, 64 * wr + r, c_); const bf16x8 h1_ = MG_FRAG(as_, 64 * wr + 32 + r, c_); \
            A[0][0] = MM(w0_, h0_, A[0][0]); A[0][1] = MM(w0_, h1_, A[0][1]); A[1][0] = MM(w1_, h0_, A[1][0]); A[1][1] = MM(w1_, h1_, A[1][1]); } \
        __builtin_amdgcn_s_setprio(0); } \
        ++s; { const int t_ = sl0; sl0 = sl1; sl1 = sl2; sl2 = t_; } } while (0)
    asm volatile("s_waitcnt vmcnt(0)" ::: "memory");
    int s = 0, sl0 = 0, sl1 = 1, sl2 = 2; MG_DMA(0, 0); MG_DMA(1, 1);
    for (int i = 0; i < 4; ++i) {
        for (int j = 0; j < 16; ++j) MG_STEP(MFMA32H);
#pragma unroll
        for (int a = 0; a < 2; ++a)
#pragma unroll
            for (int t = 0; t < 2; ++t)
#pragma unroll
                for (int k = 0; k < 8; ++k) { const float rs = t ? rs1 : rs0; S[a][t][k] = pk2(sigmoidf_(A[a][t][2 * k] * rs), sigmoidf_(A[a][t][2 * k + 1] * rs)); A[a][t][2 * k] = 0.f; A[a][t][2 * k + 1] = 0.f; }
        for (int j = 0; j < 4; ++j) MG_STEP(MFMA32);
#pragma unroll
        for (int a = 0; a < 2; ++a)
#pragma unroll
            for (int t = 0; t < 2; ++t)
#pragma unroll
                for (int k = 0; k < 8; ++k) { Uacc[a][t][2 * k] += bflo(S[a][t][k]) * A[a][t][2 * k]; Uacc[a][t][2 * k + 1] += bfhi(S[a][t][k]) * A[a][t][2 * k + 1]; A[a][t][2 * k] = 0.f; A[a][t][2 * k + 1] = 0.f; }
    }
#undef MG_DMA
#undef MG_FRAG
#undef MG_STEP
#pragma unroll
    for (int a = 0; a < 2; ++a)
#pragma unroll
        for (int t = 0; t < 2; ++t) {
            bf16* dst = U + (row0 + 64 * wr + 32 * t + r) * 1024 + c0 + 64 * wc + 32 * a;
#pragma unroll
            for (int g = 0; g < 4; ++g) { u32x2 w; w.x = pk2(Uacc[a][t][4 * g], Uacc[a][t][4 * g + 1]); w.y = pk2(Uacc[a][t][4 * g + 2], Uacc[a][t][4 * g + 3]); *(u32x2*)(dst + 8 * g + 4 * h) = w; }
        }
    __syncthreads();
}

DI void conv_one(LAS unsigned char* lds, int l, int m, int g0, int ng, LAS float* scr) {
    unsigned char* wl = WSP + WS_W + (size_t)l * W_LAYER;
    const float* W; const float* gain = nullptr; bf16* WT; int map = 0, pitch, K, rows;
    if (m == 0) { W = IN(I_F1WI) + (size_t)l * D * 2 * FF; pitch = 2 * FF; K = D; rows = 2 * FF; WT = (bf16*)(wl + WO_W1IN); map = 1; gain = IN(I_F1N) + l * D; }
    else if (m == 1) { W = IN(I_F1WO) + (size_t)l * FF * D; pitch = D; K = FF; rows = D; WT = (bf16*)(wl + WO_W1OUT); }
    else if (m == 2) { W = IN(I_WIN) + (size_t)l * D * DIN; pitch = DIN; K = D; rows = ZW; WT = (bf16*)(wl + WO_WZ); map = 2; gain = IN(I_MIXN) + l * D; }
    else if (m == 3) { W = IN(I_WIN) + (size_t)l * D * DIN; pitch = DIN; K = D; rows = 4096; WT = (bf16*)(wl + WO_WG); map = 3; gain = IN(I_MIXN) + l * D; }
    else if (m < 8) { const int i = m - 4; W = IN(I_WBR) + ((size_t)l * 4 + i) * 256 * D; pitch = D; K = 256; rows = D; WT = (bf16*)(wl + WO_WB) + (size_t)i * D * 256; }
    else if (m == 8) { W = IN(I_WOUT) + (size_t)l * D * D; pitch = D; K = D; rows = D; WT = (bf16*)(wl + WO_WO); }
    else if (m == 9) { W = IN(I_F2WI) + (size_t)l * D * 2 * FF; pitch = 2 * FF; K = D; rows = 2 * FF; WT = (bf16*)(wl + WO_W2IN); map = 1; gain = IN(I_F2N) + l * D; }
    else if (m == 10) { W = IN(I_F2WO) + (size_t)l * FF * D; pitch = D; K = FF; rows = D; WT = (bf16*)(wl + WO_W2OUT); }
    else { const int s = m - 11; W = IN(I_PW1) + ((size_t)l * 2 + s) * 2048 * 256; pitch = 256; K = 2048; rows = 256; WT = (bf16*)(wl + WO_PHI1) + (size_t)s * 256 * 2048; }
    conv_matrix(map, W, pitch, K, rows, WT, scr, g0, ng, gain, m == 0 || m == 2 || m == 3 || m == 9);
}
DI void conv_set(LAS unsigned char* lds, int l, unsigned mask, int g0, int ng, LAS float* scr) {
    for (int m = 0; m < 13; ++m) if ((mask >> m) & 1u) conv_one(lds, l, m, g0, ng, scr);
}
#ifdef NO_DIFF
#define SK_DIFF(...)
#else
#define SK_DIFF(...) __VA_ARGS__
#endif
#ifdef NO_FOX
#define SK_FOX(...)
#else
#define SK_FOX(...) __VA_ARGS__
#endif
#ifdef NO_NSA
#define SK_NSA(...)
#else
#define SK_NSA(...) __VA_ARGS__
#endif
#ifdef NO_GMLP
#define SK_GMLP(...)
#else
#define SK_GMLP(...) __VA_ARGS__
#endif
#ifdef NO_MERGE
#define SK_MERGE(...)
#else
#define SK_MERGE(...) __VA_ARGS__
#endif
#ifdef NO_GZ
#define SK_GZ(...)
#else
#define SK_GZ(...) __VA_ARGS__
#endif
#ifdef NO_GS
#define SK_GS(...)
#else
#define SK_GS(...) __VA_ARGS__
#endif
#ifdef NO_GR
#define SK_GR(...)
#else
#define SK_GR(...) __VA_ARGS__
#endif
#ifdef NO_CMP
#define SK_CMP(...)
#else
#define SK_CMP(...) __VA_ARGS__
#endif
__global__ void __launch_bounds__(NTHR, 2) mega_fwd(Args args) {
    extern __shared__ __attribute__((aligned(16))) unsigned char lds_raw[];
    LAS unsigned char* lds = (LAS unsigned char*)lds_raw;
    cg::grid_group grid = cg::this_grid();
    const int tid = threadIdx.x, lane = tid & 63, wid = __builtin_amdgcn_readfirstlane(tid >> 6);
    if (lane == 0) *(LAS unsigned*)(uintptr_t)(WIDTAB_OFF + 4u * ((unsigned)__builtin_amdgcn_s_getreg((5 << 11) | 4) & 63u)) = (unsigned)wid;
    const int G = gridDim.x, bx = blockIdx.x;
    const int gw = bx * NWAVE + wid, ngw = G * NWAVE;
    if (tid < N_IN + 2) { const unsigned long long v = (tid < N_IN) ? (unsigned long long)args.in[tid < N_IN ? tid : 0] : (tid == N_IN ? (unsigned long long)args.out : (unsigned long long)args.ws);
        *(LAS unsigned long long*)(lds + PTAB_OFF + 8 * tid) = v; }
    if (tid < 2) ((LAS unsigned*)(lds + PTAB_OFF + 512))[tid] = 0u;
    __syncthreads();
    (void)xcd_barrier_post((unsigned*)(WSP + WS_CTL) + 4096, (volatile LAS unsigned*)(lds + PTAB_OFF + 512));
#define GSYNC() do { XcdBarrier b_; b_.bar = (unsigned*)(WSP + WS_CTL) + 4096; b_.x = xb_xcc_id(); b_.st = (volatile LAS unsigned*)(lds + PTAB_OFF + 512); xcd_barrier(b_); } while (0)
#define Hb ((bf16*)(WSP + WS_H))
#define BR ((bf16*)(WSP + WS_BR))
#define BIG ((bf16*)(WSP + WS_BIG))
#define MISC ((float*)(WSP + WS_MISC))
#define CUM ((float*)(WSP + WS_CUM))
#define KC ((bf16*)(WSP + WS_KC))
#define VC ((bf16*)(WSP + WS_VC))
#define SSB ((float*)(WSP + WS_SS))

    {
        LAS float* scr = (LAS float*)(lds + wid * 16384);
        conv_set(lds, 0, (1u << 0) | (1u << 3) | (1u << 9) | (1u << 10), gw, ngw, scr);
        for (int l = 1; l < DEPTH; ++l) conv_set(lds, l, (1u << 9) | (1u << 10), gw, ngw, scr);
        cast_rows(IN(I_X), Hb, SSB, (unsigned short*)OUTP, gw, ngw);
    }
    if (args.ws == nullptr) grid.sync();
    GSYNC();

    for (int l = 0; l < DEPTH; ++l) {
        unsigned char* wl = WSP + WS_W + (size_t)l * W_LAYER;
        { pg8::Gemm g{(const bf16*)OUTP, (const bf16*)(wl + WO_W1IN), M, 2 * FF, D}; pg8::StaticOrder S; S.init(M, 2 * FF, G, obx()); EpiSwiglu E{lds};
          SK_GS(pg8::gemm_phase<EpiSwiglu, pg8::StaticOrder, true, true, true>(lds, g, S, E)); }
        if (G == 256 && bx >= 128) conv_set(lds, l, (1u << 1) | (1u << 2), (bx - 128) * NWAVE + wid, 128 * NWAVE, (LAS float*)(lds + wid * 16384));
        else if (G != 256) conv_set(lds, l, (1u << 1) | (1u << 2), gw, ngw, (LAS float*)(lds + wid * 16384));
        GSYNC();
        { pg8::Gemm g{BIG, (const bf16*)(wl + WO_W1OUT), M, D, FF}; pg8::StaticOrder S; S.init(M, D, G, obx()); EpiResid E{lds, 1, 1, 0.5f};
          SK_GR(pg8::gemm_phase<EpiResid, pg8::StaticOrder, true, true>(lds, g, S, E)); }
        GSYNC();
        { pg8::Gemm g{(const bf16*)OUTP, (const bf16*)(wl + WO_WZ), M, ZW, D}; pg8::StaticOrder S; S.init(M, ZW, G, obx());
          EpiZ E{lds, l};
          SK_GZ(pg8::gemm_phase<EpiZ, pg8::StaticOrder, true, true, true>(lds, g, S, E)); }
        if (G == 256 && bx >= 192) conv_set(lds, l, 0xf0u | (1u << 8) | (3u << 11), (bx - 192) * NWAVE + wid, 64 * NWAVE, (LAS float*)(lds + wid * 16384));
        else if (G != 256) conv_set(lds, l, 0xf0u | (1u << 8) | (3u << 11), gw, ngw, (LAS float*)(lds + wid * 16384));
        GSYNC();
        {
            float lam, lam_init;
            { const float* lp = IN(I_DLAM) + l * 128; float s01 = 0.f, s23 = 0.f; for (int i = 0; i < 32; ++i) { s01 += lp[i] * lp[32 + i]; s23 += lp[64 + i] * lp[96 + i]; }
              lam_init = 0.8f - 0.6f * __expf(-0.3f * (float)l); lam = __expf(s01) - __expf(s23) + lam_init; }
            unsigned* ctr = (unsigned*)(WSP + WS_CTL) + 64 * (1 + l);
            unsigned* dcum = (unsigned*)(WSP + WS_CTL) + 64 * (4 + 2 * l);
            unsigned* dcmp = (unsigned*)(WSP + WS_CTL) + 64 * (5 + 2 * l);
            LAS int* slot = (LAS int*)(lds + L_Q);
#define DEP_WAIT(p_, n_) do { if (otid() == 0) { while (__hip_atomic_load((p_), __ATOMIC_RELAXED, __HIP_MEMORY_SCOPE_AGENT) < (unsigned)(n_)) __builtin_amdgcn_s_sleep(2); \
        __builtin_amdgcn_fence(__ATOMIC_ACQUIRE, "agent"); asm volatile("s_waitcnt vmcnt(0)" ::: "memory"); } __syncthreads(); } while (0)
            for (;;) {
                __syncthreads();
                if (otid() == 0) *slot = (int)atomicAdd(ctr, 1u);
                __syncthreads();
                const int u0 = *slot;
                if (u0 >= 72 + 768 + 512) break;
                if (u0 < 72) {
                    if (u0 < 8) cumsum_unit(u0 >> 2, u0 & 3, MISC, CUM, (LAS char*)lds);
                    else { SK_CMP( const int v = u0 - 8; const int s = v >> 5; const int b = (v >> 4) & 1; const int nb = v & 15;
                        compress_unit(l, s, b, nb, BIG, (const bf16*)(wl + WO_PHI1) + (size_t)s * 256 * 2048, IN(I_PE) + ((size_t)l * 2 + s) * 2048, IN(I_PB1) + (l * 2 + s) * 256,
                                      IN(I_PW2) + ((size_t)l * 2 + s) * 256 * 64, IN(I_PB2) + (l * 2 + s) * 64, IN(I_NKG) + l * 64, s == 0 ? KC : VC, (LAS char*)lds); ) }
                    asm volatile("s_waitcnt vmcnt(0)" ::: "memory"); __syncthreads();
                    if (otid() == 0) { __builtin_amdgcn_fence(__ATOMIC_RELEASE, "agent"); asm volatile("s_waitcnt vmcnt(0)" ::: "memory");
                        __hip_atomic_fetch_add(u0 < 8 ? dcum : dcmp, 1u, __ATOMIC_RELAXED, __HIP_MEMORY_SCOPE_AGENT); }
                    continue;
                }
                const int v = u0 - 72;
                int kind, lvl, k;
                if (v < 160) { kind = 0; lvl = 31 - (v >> 3); k = v & 7; }
                else if (v >= 512 && v < 768) { const int w = v - 512; kind = 1; lvl = 31 - (w >> 3); k = w & 7; }
                else if (v < 512) { int w = v - 160; kind = 2; lvl = 0; k = 0;
                    for (int i = 0; i < 32; ++i) {
                        if (w < 8) { kind = 2; lvl = 31 - i; k = w; break; } w -= 8;
                        const int dl = (i == 31) ? 0 : ((i % 3 == 0) ? 11 - i / 3 : -1);
                        if (dl >= 0) { if (w < 8) { kind = 0; lvl = dl; k = w; break; } w -= 8; }
                    } }
                else { kind = 3; lvl = 0; k = v - 768; }
                if (kind == 0) {
                    const float bnd = 32.f * 0.17677669529663687f * LOG2E * 1.01f * gain_max(IN(I_DQG) + l * 32, 32) * gain_max(IN(I_DKG) + l * 32, 32);
                    if (bnd > 60.f) { SK_DIFF(attn_unit<true, true>(k >> 2, k & 3, lvl, BIG, CUM, BR, lam, lam_init, nullptr, (LAS char*)lds)); }
                    else { SK_DIFF(attn_unit<true, false>(k >> 2, k & 3, lvl, BIG, CUM, BR, lam, lam_init, nullptr, (LAS char*)lds)); } }
                else if (kind == 1) { DEP_WAIT(dcum, 8); SK_FOX(attn_unit<false>(k >> 2, k & 3, lvl, BIG, CUM, BR, lam, lam_init, IN(I_FKG) + l * 64, (LAS char*)lds)); }
                else if (kind == 2) { DEP_WAIT(dcmp, 64); SK_NSA(nsa_unit(k & 1, 4 * lvl + 3 - (k >> 1), BIG, KC, VC, MISC, BR, (LAS char*)lds)); }
                else { SK_GMLP(gmlp_unit(k >> 8, (k >> 2) & 63, k & 3, l, BIG, IN(I_GWS), IN(I_GBS), BR, (LAS char*)lds)); }
            }
#undef DEP_WAIT
        }
        GSYNC();
        for (int u = ((G % 8 == 0) ? (bx % 8) * (G / 8) + bx / 8 : bx); u < 64 * 8; u += G) { SK_MERGE(merge_unit(u >> 3, u & 7,     (const bf16*)OUTP, BR, (const bf16*)(wl + WO_WG), (const bf16*)(wl + WO_WB), BIG, SSB, (LAS char*)lds)); }
        GSYNC();
        { pg8::Gemm g{BIG, (const bf16*)(wl + WO_WO), M, D, D}; pg8::StaticOrder S; S.init(M, D, G, obx()); EpiResid E{lds, 1, (l + 1 == DEPTH) ? 2 : 1, 1.0f};
          SK_GR(pg8::gemm_phase<EpiResid, pg8::StaticOrder, true, true>(lds, g, S, E)); }
        GSYNC();
        { pg8::Gemm g{(l + 1 == DEPTH) ? (const bf16*)BR : (const bf16*)OUTP, (const bf16*)(wl + WO_W2IN), M, 2 * FF, D}; pg8::StaticOrder S; S.init(M, 2 * FF, G, obx()); EpiSwiglu E{lds};
          SK_GS(pg8::gemm_phase<EpiSwiglu, pg8::StaticOrder, true, true, true>(lds, g, S, E)); }
        if (l + 1 < DEPTH) { if (G == 256 && bx >= 128) conv_set(lds, l + 1, (1u << 0) | (1u << 3), (bx - 128) * NWAVE + wid, 128 * NWAVE, (LAS float*)(lds + wid * 16384));
            else if (G != 256) conv_set(lds, l + 1, (1u << 0) | (1u << 3), gw, ngw, (LAS float*)(lds + wid * 16384)); }
        GSYNC();
        { pg8::Gemm g{BIG, (const bf16*)(wl + WO_W2OUT), M, D, FF}; pg8::StaticOrder S; S.init(M, D, G, obx()); EpiResid E{lds, (l + 1 == DEPTH) ? 2 : 1, (l + 1 == DEPTH) ? 3 : 1, 0.5f};
          SK_GR(pg8::gemm_phase<EpiResid, pg8::StaticOrder, true, true>(lds, g, S, E)); }
        if (l + 1 < DEPTH) { GSYNC(); }
    }
}

extern "C" void kernel_launch(void* const* d_in, const int* in_sizes, int n_in, void* d_out, int out_size, void* d_ws, size_t ws_size, hipStream_t stream) {
    static int grid = 0;
    if (grid == 0) {
        if (n_in != N_IN || out_size != M * D || ws_size < WS_END) { fprintf(stderr, "kernel_launch: unexpected shapes n_in %d out %d ws %zu (need %zu)\n", n_in, out_size, ws_size, (size_t)WS_END); grid = -1; return; }
        int dev = 0, cus = 0, per_cu = 0;
        hipGetDevice(&dev); hipDeviceGetAttribute(&cus, hipDeviceAttributeMultiprocessorCount, dev);
        hipFuncSetAttribute((const void*)mega_fwd, hipFuncAttributeMaxDynamicSharedMemorySize, LDS_BYTES);
        hipOccupancyMaxActiveBlocksPerMultiprocessor(&per_cu, (const void*)mega_fwd, NTHR, LDS_BYTES);
        if (per_cu < 1) { fprintf(stderr, "kernel_launch: occupancy query says %d blocks/CU\n", per_cu); per_cu = 1; }
        if (per_cu > 1) per_cu = 1;
        grid = cus * per_cu;
    }
    if (grid < 0) return;
    hipMemsetAsync((char*)d_ws + WS_CTL, 0, 65536, stream);
    Args a{};
    for (int i = 0; i < N_IN; ++i) a.in[i] = (const float*)d_in[i];
    a.out = (float*)d_out; a.ws = (unsigned char*)d_ws;
    void* kargs[] = {&a};
    hipError_t e = hipLaunchCooperativeKernel((const void*)mega_fwd, dim3(grid), dim3(NTHR), kargs, LDS_BYTES, stream);
    if (e != hipSuccess) fprintf(stderr, "cooperative launch failed: %s (grid %d)\n", hipGetErrorString(e), grid);
}
```
